# Optimizing an MI355X kernel written in HIP

```python
import math
import jax, jax.numpy as jnp
from jax import lax
import numpy as np

D_MODEL = 1024
BATCH = 4
SEQ = 8192
DEPTH = 2

CHUNK = 64
QBLOCK = 128
EPS = 1e-6
NEG_INF = -1e30

LRU_WIDTH = 512
LRU_HEADS = 8
LRU_HEAD_DIM = LRU_WIDTH // LRU_HEADS
CONV_WIDTH = 4
LRU_C = 8.0

MLA_HEADS = 8
MLA_Q_LORA = 384
MLA_KV_LORA = 256
MLA_NOPE = 64
MLA_ROPE = 32
MLA_V = 64
ROPE_BASE = 10000.0

FOX_HEADS = 8
FOX_HEAD_DIM = 64
FOX_WIDTH = FOX_HEADS * FOX_HEAD_DIM

N_BRANCH = 3
D_FF = ((8 * D_MODEL // 3 + 255) // 256) * 256
PLE_DIM = 256

SPLIT_SIZES = (
    LRU_WIDTH,
    LRU_WIDTH,
    MLA_Q_LORA,
    MLA_KV_LORA + MLA_ROPE,
    FOX_WIDTH,
    FOX_WIDTH,
    FOX_WIDTH,
    FOX_HEADS,
    N_BRANCH * D_MODEL,
)
D_IN = 2 * LRU_WIDTH + MLA_Q_LORA + MLA_KV_LORA + MLA_ROPE + 3 * FOX_WIDTH + FOX_HEADS + N_BRANCH * D_MODEL

kernel_name = "hybrid_gated_rglru_mla_fox_encoder"


def rmsnorm(x, g):
    xf = x.astype(jnp.float32)
    y = xf * lax.rsqrt(jnp.mean(xf * xf, axis=-1, keepdims=True) + EPS)
    return (y * g.astype(jnp.float32)).astype(x.dtype)


def split_columns(z):
    idx = []
    acc = 0
    for s in SPLIT_SIZES[:-1]:
        acc += s
        idx.append(acc)
    return jnp.split(z, idx, axis=-1)


def rope(x, cos, sin):
    half = x.shape[-1] // 2
    x1, x2 = x[..., :half], x[..., half:]
    c = cos[None, :, None, :].astype(x.dtype)
    s = sin[None, :, None, :].astype(x.dtype)
    return jnp.concatenate([x1 * c - x2 * s, x2 * c + x1 * s], axis=-1)


def block_attention(q, k, v, scale, unit, decay=None):
    B, S, H, Dk = q.shape
    nb = S // QBLOCK
    q_blocks = q.reshape(B, nb, QBLOCK, H, Dk).transpose(1, 0, 2, 3, 4)
    key_unit = jnp.arange(S) // unit
    decay_t = None if decay is None else decay.transpose(0, 2, 1)

    def one_block(args):
        ib, q_blk = args
        s = jnp.einsum('bqhd,bkhd->bhqk', q_blk, k, preferred_element_type=jnp.float32) * scale
        if decay_t is not None:
            dq = lax.dynamic_slice_in_dim(decay_t, ib * QBLOCK, QBLOCK, axis=2)
            s = s + dq[:, :, :, None] - decay_t[:, :, None, :]
        q_unit = (ib * QBLOCK + jnp.arange(QBLOCK)) // unit
        mask = q_unit[:, None] >= key_unit[None, :]
        s = jnp.where(mask[None, None], s, NEG_INF)
        pr = jax.nn.softmax(s, axis=-1)
        return jnp.einsum('bhqk,bkhd->bqhd', pr.astype(v.dtype), v)

    out = lax.map(one_block, (jnp.arange(nb), q_blocks))
    return out.transpose(1, 0, 2, 3, 4).reshape(B, S, H, v.shape[-1])


def _lru_combine(left, right):
    a1, b1 = left
    a2, b2 = right
    return a1 * a2, a2 * b1 + b2


def rglru_branch(u, u_gate, conv_w, conv_b, wa, ba, wx, bx, lam):
    B, S, W = u.shape
    up = jnp.pad(u, ((0, 0), (CONV_WIDTH - 1, 0), (0, 0)))
    xc = conv_b + up[:, 0:S] * conv_w[0]
    for kk in range(1, CONV_WIDTH):
        xc = xc + up[:, kk:kk + S] * conv_w[kk]
    xh = xc.reshape(B, S, LRU_HEADS, LRU_HEAD_DIM)
    r = jax.nn.sigmoid(jnp.einsum('bshi,hij->bshj', xh, wa).reshape(B, S, W) + ba)
    ig = jax.nn.sigmoid(jnp.einsum('bshi,hij->bshj', xh, wx).reshape(B, S, W) + bx)
    log_a = -LRU_C * r.astype(jnp.float32) * jax.nn.softplus(-lam.astype(jnp.float32))
    a = jnp.exp(log_a)
    b = jnp.sqrt(-jnp.expm1(2.0 * log_a)) * (ig * xc).astype(jnp.float32)
    _, h = lax.associative_scan(_lru_combine, (a, b), axis=1)
    return h.astype(u.dtype) * jax.nn.gelu(u_gate)


def mla_branch(c_q, ckv_rope, q_norm, wuq, kv_norm, wukv, cos, sin):
    B, S, _ = c_q.shape
    q = (rmsnorm(c_q, q_norm) @ wuq).reshape(B, S, MLA_HEADS, MLA_NOPE + MLA_ROPE)
    q_nope, q_rope = q[..., :MLA_NOPE], q[..., MLA_NOPE:]
    c_kv, k_rope = ckv_rope[..., :MLA_KV_LORA], ckv_rope[..., MLA_KV_LORA:]
    kv = (rmsnorm(c_kv, kv_norm) @ wukv).reshape(B, S, MLA_HEADS, MLA_NOPE + MLA_V)
    k_nope, v = kv[..., :MLA_NOPE], kv[..., MLA_NOPE:]
    q_rope = rope(q_rope, cos, sin)
    k_rope = rope(k_rope[:, :, None, :], cos, sin)
    q_full = jnp.concatenate([q_nope, q_rope], axis=-1)
    k_full = jnp.concatenate([k_nope, jnp.broadcast_to(k_rope, (B, S, MLA_HEADS, MLA_ROPE))], axis=-1)
    o = block_attention(q_full, k_full, v, (MLA_NOPE + MLA_ROPE) ** -0.5, CHUNK)
    return o.reshape(B, S, MLA_HEADS * MLA_V)


def fox_branch(fq, fk, fv, f_logit, bf):
    B, S, _ = fq.shape
    q = fq.reshape(B, S, FOX_HEADS, FOX_HEAD_DIM)
    k = fk.reshape(B, S, FOX_HEADS, FOX_HEAD_DIM)
    v = fv.reshape(B, S, FOX_HEADS, FOX_HEAD_DIM)
    log_f = jax.nn.log_sigmoid((f_logit + bf).astype(jnp.float32))
    cum = jnp.cumsum(log_f, axis=1)
    o = block_attention(q, k, v, FOX_HEAD_DIM ** -0.5, 1, decay=cum)
    return o.reshape(B, S, FOX_WIDTH)


def setup_inputs(seed: int = 0) -> dict:
    key = jax.random.key(seed)
    ks = jax.random.split(key, 32)

    def nrm(k, shape, scale):
        return jax.random.normal(k, shape, jnp.float32) * scale

    def gain(k, shape):
        return 1.0 + 0.05 * jax.random.normal(k, shape, jnp.float32)

    u = jax.random.uniform(ks[10], (DEPTH, LRU_WIDTH), jnp.float32, 0.9, 0.999)
    a = u ** (1.0 / LRU_C)
    lru_lambda = jnp.log(a) - jnp.log1p(-a)

    return {
        "x": nrm(ks[0], (BATCH, SEQ, D_MODEL), 1.0),
        "p": nrm(ks[1], (DEPTH, BATCH, SEQ, PLE_DIM), 1.0),
        "mix_norm": gain(ks[2], (DEPTH, D_MODEL)),
        "w_in": nrm(ks[3], (DEPTH, D_MODEL, D_IN), D_MODEL ** -0.5),
        "gate_b": nrm(ks[4], (DEPTH, N_BRANCH * D_MODEL), 0.1),
        "conv_w": nrm(ks[5], (DEPTH, CONV_WIDTH, LRU_WIDTH), CONV_WIDTH ** -0.5),
        "conv_b": nrm(ks[6], (DEPTH, LRU_WIDTH), 0.1),
        "lru_wa": nrm(ks[7], (DEPTH, LRU_HEADS, LRU_HEAD_DIM, LRU_HEAD_DIM), LRU_HEAD_DIM ** -0.5),
        "lru_ba": nrm(ks[8], (DEPTH, LRU_WIDTH), 0.1),
        "lru_wx": nrm(ks[9], (DEPTH, LRU_HEADS, LRU_HEAD_DIM, LRU_HEAD_DIM), LRU_HEAD_DIM ** -0.5),
        "lru_bx": nrm(ks[11], (DEPTH, LRU_WIDTH), 0.1),
        "lru_lambda": lru_lambda,
        "mla_q_norm": gain(ks[12], (DEPTH, MLA_Q_LORA)),
        "mla_wuq": nrm(ks[13], (DEPTH, MLA_Q_LORA, MLA_HEADS * (MLA_NOPE + MLA_ROPE)), MLA_Q_LORA ** -0.5),
        "mla_kv_norm": gain(ks[14], (DEPTH, MLA_KV_LORA)),
        "mla_wukv": nrm(ks[15], (DEPTH, MLA_KV_LORA, MLA_HEADS * (MLA_NOPE + MLA_V)), MLA_KV_LORA ** -0.5),
        "fox_bf": jax.random.uniform(ks[16], (DEPTH, FOX_HEADS), jnp.float32, 1.0, 5.0),
        "w_br_a": nrm(ks[17], (DEPTH, LRU_WIDTH, D_MODEL), LRU_WIDTH ** -0.5),
        "w_br_b": nrm(ks[18], (DEPTH, MLA_HEADS * MLA_V, D_MODEL), (MLA_HEADS * MLA_V) ** -0.5),
        "w_br_c": nrm(ks[19], (DEPTH, FOX_WIDTH, D_MODEL), FOX_WIDTH ** -0.5),
        "w_o": nrm(ks[20], (DEPTH, D_MODEL, D_MODEL), D_MODEL ** -0.5),
        "ffn_norm": gain(ks[21], (DEPTH, D_MODEL)),
        "w_gate_up": nrm(ks[22], (DEPTH, D_MODEL, 2 * D_FF), D_MODEL ** -0.5),
        "w_down": nrm(ks[23], (DEPTH, D_FF, D_MODEL), D_FF ** -0.5),
        "ple_norm": gain(ks[24], (DEPTH, D_MODEL)),
        "w_ple_gate": nrm(ks[25], (DEPTH, D_MODEL, D_MODEL), D_MODEL ** -0.5),
        "w_ple": nrm(ks[26], (DEPTH, PLE_DIM, D_MODEL), PLE_DIM ** -0.5),
        "final_norm": gain(ks[27], (D_MODEL,)),
    }


def reference(x, p, mix_norm, w_in, gate_b, conv_w, conv_b, lru_wa, lru_ba, lru_wx, lru_bx, lru_lambda,
              mla_q_norm, mla_wuq, mla_kv_norm, mla_wukv, fox_bf, w_br_a, w_br_b, w_br_c, w_o,
              ffn_norm, w_gate_up, w_down, ple_norm, w_ple_gate, w_ple, final_norm):
    B, S, D = x.shape
    pos = jnp.arange(S, dtype=jnp.float32)
    inv_freq = ROPE_BASE ** (-jnp.arange(0, MLA_ROPE, 2, dtype=jnp.float32) / MLA_ROPE)
    ang = pos[:, None] * inv_freq[None, :]
    cos, sin = jnp.cos(ang), jnp.sin(ang)

    for i in range(DEPTH):
        h = rmsnorm(x, mix_norm[i])
        z = h @ w_in[i]
        u_rnn, u_gelu, c_q, ckv_rope, fq, fk, fv, f_logit, gate_logit = split_columns(z)
        y_a = rglru_branch(u_rnn, u_gelu, conv_w[i], conv_b[i], lru_wa[i], lru_ba[i],
                           lru_wx[i], lru_bx[i], lru_lambda[i]) @ w_br_a[i]
        y_b = mla_branch(c_q, ckv_rope, mla_q_norm[i], mla_wuq[i], mla_kv_norm[i],
                         mla_wukv[i], cos, sin) @ w_br_b[i]
        y_c = fox_branch(fq, fk, fv, f_logit, fox_bf[i]) @ w_br_c[i]
        g = jax.nn.sigmoid(gate_logit + gate_b[i]).reshape(B, S, N_BRANCH, D)
        merged = g[:, :, 0] * y_a + g[:, :, 1] * y_b + g[:, :, 2] * y_c
        x = x + merged @ w_o[i]
        hf = rmsnorm(x, ffn_norm[i]) @ w_gate_up[i]
        x = x + (jax.nn.silu(hf[..., :D_FF]) * hf[..., D_FF:]) @ w_down[i]
        pg = jax.nn.sigmoid(rmsnorm(x, ple_norm[i]) @ w_ple_gate[i])
        x = x + pg * (p[i] @ w_ple[i])
    return rmsnorm(x, final_norm)
```

```cpp
#include <hip/hip_runtime.h>
#include <hip/hip_cooperative_groups.h>
#include <cstdio>
#include <cstdint>
namespace cg = cooperative_groups;

#ifndef MK_MULTI
#define MK_MULTI 0
#endif

#define DEVI __device__ __forceinline__
typedef unsigned short bf16_t;
typedef short bf16x8 __attribute__((ext_vector_type(8)));
typedef float f32x4 __attribute__((ext_vector_type(4)));
typedef float f32x16 __attribute__((ext_vector_type(16)));
typedef unsigned u32x2 __attribute__((ext_vector_type(2)));
typedef unsigned u32x4 __attribute__((ext_vector_type(4)));
typedef float f32x2_t __attribute__((ext_vector_type(2)));
typedef __bf16 bf16x2_t __attribute__((ext_vector_type(2)));

constexpr int T_ = 32768, S_ = 8192, NZ = 2816;
constexpr float EPS = 1e-6f, LOG2E = 1.4426950408889634f;
constexpr float QSCALE_MLA = 0.10206207261596575f * 1.4426950408889634f;
constexpr float QSCALE_FOX = 0.125f * 1.4426950408889634f;

DEVI unsigned cvtpk(float lo, float hi) { f32x2_t v = {lo, hi}; bf16x2_t b = __builtin_convertvector(v, bf16x2_t); return __builtin_bit_cast(unsigned, b); }
DEVI bf16_t f2bf(float x) { return (bf16_t)(cvtpk(x, 0.f) & 0xffffu); }
DEVI float bf2f(bf16_t v) { return __uint_as_float(((unsigned)v) << 16); }
DEVI float bflo(unsigned w) { return __uint_as_float(w << 16); }
DEVI float bfhi(unsigned w) { return __uint_as_float(w & 0xffff0000u); }
DEVI float sigm(float x) { return __builtin_amdgcn_rcpf(1.f + __builtin_amdgcn_exp2f(-1.4426950408889634f * x)); }
DEVI float logsig(float x) { return fminf(x, 0.f) - log1pf(expf(-fabsf(x))); }
DEVI int otid() { int t = threadIdx.x; asm volatile("" : "+v"(t)); return t; }
DEVI int crow(int r, int hi) { return (r & 3) + 8 * (r >> 2) + 4 * hi; }

namespace pg8 {
#define PG8_LAS __attribute__((address_space(3)))
constexpr int BM = 256, BK = 64, HALF = 128, HTB = HALF * BK * 2, STAGE_BYTES = 8 * HTB, NXCD = 8, WGM = 8;
__host__ __device__ __forceinline__ int lds_byte(int r, int c) { const int st = (r >> 4) * 2 + (c >> 5), rr = r & 15, cc = c & 31, ob = rr * 64 + cc * 2; return st * 1024 + (ob ^ (((ob >> 9) & 1) << 5)); }
__host__ __device__ __forceinline__ void stage_rc(int b, int& R, int& C) { const int st = b / 1024, sb = b % 1024, swz = sb ^ (((sb >> 9) & 1) << 5); R = (st >> 1) * 16 + swz / 64; C = (st & 1) * 32 + (swz % 64) / 2; }
struct Unit { int pm, pn; };
struct Gemm { const bf16_t* A; const bf16_t* Bt; int M, N, K, lda, ldb, perm; };
__host__ __device__ __forceinline__ int perm32(int rho) { const int n = rho >> 4, i = rho & 15; return 8 * (i >> 2) + 4 * n + (i & 3); }
struct StaticOrder {
    int nM, nN, nwg, G, c;
    __device__ void init(int M, int N, int G_, int c_) { nM = M / BM; nN = N / BM; nwg = nM * nN; G = G_; c = c_; }
    __device__ bool next(int i, Unit& u) const {
        const long L = (long)i * G + c; if (L >= nwg) return false;
        int wgid = (int)L; { const int q = nwg / NXCD, r = nwg % NXCD, xcd = wgid % NXCD, off = wgid / NXCD; wgid = (xcd < r ? xcd * (q + 1) : r * (q + 1) + (xcd - r) * q) + off; }
        const int nig = WGM * nN, gid = wgid / nig, fm = gid * WGM, gsz = (nM - fm) < WGM ? (nM - fm) : WGM;
        u.pm = fm + ((wgid % nig) % gsz); u.pn = (wgid % nig) / gsz; return true;
    }
    __device__ __forceinline__ void a_ready(const Unit&) const {}
    __device__ __forceinline__ void done(const Unit&) const {}
};

template <class Epi, class Sched, bool ALIGN_EPI = false, bool SP2 = false>
__device__ __forceinline__ void gemm_phase(PG8_LAS unsigned char* lds, const Gemm g, const Sched& S, const Epi& E) {
    const int tid = otid(), wid = __builtin_amdgcn_readfirstlane(tid >> 6), lane = tid & 63, wr = wid >> 2, wc = wid & 3, fr = lane & 15, fq = lane >> 4;
    const int K = g.K, nt = K / BK;
    unsigned voffA[2], voffB[2];
#pragma unroll
    for (int i = 0; i < 2; ++i) { int R, C; stage_rc(tid * 16 + i * 8192, R, C);
        const int Rb = g.perm ? ((R & ~31) + perm32(R & 31)) : R;
        voffA[i] = (unsigned)(R * g.lda + C) * 2u; voffB[i] = (unsigned)(Rb * g.ldb + C) * 2u; }
    const size_t kstep = (size_t)(BK * 2);
    const size_t hstepA = (size_t)HALF * g.lda * 2, hstepB = (size_t)HALF * g.ldb * 2;
    const size_t tstepA = 2 * hstepA, tstepB = 2 * hstepB;
    const unsigned ldsw = (unsigned)wid * 1024u;
    const int aoff = lds_byte(wr * 64 + fr, fq * 8), boff = lds_byte(wc * 32 + fr, fq * 8);
#define PG8_SA(b, h) (((b) * 2 + (h)) * HTB)
#define PG8_SB(b, h) ((4 + (b) * 2 + (h)) * HTB)
#define PG8_STAGE(bufoff, gbase, voff) do { _Pragma("unroll") for (int _i = 0; _i < 2; ++_i) \
        __builtin_amdgcn_global_load_lds((const unsigned*)((const char*)(gbase) + (voff)[_i]), (PG8_LAS unsigned*)(lds + (bufoff) + ldsw + _i * 8192), 16, 0, 0); } while (0)
#define PG8_LDA(dst, b, h) do { _Pragma("unroll") for (int m = 0; m < 4; ++m) _Pragma("unroll") for (int k = 0; k < 2; ++k) dst[m][k] = *(const PG8_LAS bf16x8*)(lds + PG8_SA(b, h) + aoff + m * 2048 + k * 1024); } while (0)
#define PG8_LDB(dst, b, h) do { _Pragma("unroll") for (int n = 0; n < 2; ++n) _Pragma("unroll") for (int k = 0; k < 2; ++k) dst[n][k] = *(const PG8_LAS bf16x8*)(lds + PG8_SB(b, h) + boff + n * 2048 + k * 1024); } while (0)
#define PG8_MMA(ai, bj, At, Bt) do { __builtin_amdgcn_s_setprio(1); _Pragma("unroll") for (int m = 0; m < 4; ++m) _Pragma("unroll") for (int n = 0; n < 2; ++n) _Pragma("unroll") for (int k = 0; k < 2; ++k) \
        acc[ai][bj][m][n] = __builtin_amdgcn_mfma_f32_16x16x32_bf16(Bt[n][k], At[m][k], acc[ai][bj][m][n], 0, 0, 0); __builtin_amdgcn_s_setprio(0); } while (0)
#define PG8_WAIT_V(n) asm volatile("s_waitcnt vmcnt(" #n ")" ::: "memory")
#define PG8_WAIT_L(n) asm volatile("s_waitcnt lgkmcnt(" #n ")" ::: "memory")
#define PG8_BAR __builtin_amdgcn_s_barrier()
#define PG8_SCHED __builtin_amdgcn_sched_barrier(0)
    Unit cur, nxt; int ui = 0;
    if (!S.next(0, cur)) return;
    f32x4 acc[2][2][4][2];
#pragma unroll
    for (int a = 0; a < 2; ++a)
#pragma unroll
        for (int b = 0; b < 2; ++b)
#pragma unroll
            for (int m = 0; m < 4; ++m)
#pragma unroll
                for (int n = 0; n < 2; ++n) acc[a][b][m][n] = (f32x4){0.f, 0.f, 0.f, 0.f};
    bf16x8 At[4][2], B0[2][2], B1[2][2];
    const char* cA = (const char*)g.A + (size_t)cur.pm * tstepA; const char* cB = (const char*)g.Bt + (size_t)cur.pn * tstepB;
    S.a_ready(cur);
    if constexpr (SP2) {
        PG8_STAGE(PG8_SB(0, 0), cB, voffB); PG8_STAGE(PG8_SB(0, 1), cB + hstepB, voffB); PG8_STAGE(PG8_SA(0, 0), cA, voffA); PG8_STAGE(PG8_SA(0, 1), cA + hstepA, voffA);
        if (wr == 1) PG8_BAR;
        PG8_WAIT_V(2); PG8_BAR;
        PG8_STAGE(PG8_SB(1, 0), cB + kstep, voffB); PG8_STAGE(PG8_SA(1, 0), cA + kstep, voffA); PG8_STAGE(PG8_SB(1, 1), cB + hstepB + kstep, voffB);
        PG8_WAIT_V(6); PG8_BAR;
    } else {
        PG8_STAGE(PG8_SB(0, 0), cB, voffB); PG8_STAGE(PG8_SA(0, 0), cA, voffA); PG8_STAGE(PG8_SB(0, 1), cB + hstepB, voffB); PG8_STAGE(PG8_SA(0, 1), cA + hstepA, voffA);
        if (wr == 1) PG8_BAR;
        PG8_WAIT_V(4); PG8_BAR;
        PG8_STAGE(PG8_SB(1, 0), cB + kstep, voffB); PG8_STAGE(PG8_SA(1, 0), cA + kstep, voffA); PG8_STAGE(PG8_SB(1, 1), cB + hstepB + kstep, voffB);
        PG8_WAIT_V(6); PG8_BAR;
    }
    for (;;) {
        const bool has_next = S.next(ui + 1, nxt);
        const char* nA = has_next ? (const char*)g.A + (size_t)nxt.pm * tstepA : cA; const char* nB = has_next ? (const char*)g.Bt + (size_t)nxt.pn * tstepB : cB;
        for (int t = 0; t < nt; t += 2) {
            const bool last = (t == nt - 2);
            const char* a1 = cA + (size_t)(t + 1) * kstep;
            const char* a2 = last ? nA : cA + (size_t)(t + 2) * kstep; const char* b2 = last ? nB : cB + (size_t)(t + 2) * kstep;
            const char* a3 = a2 + kstep; const char* b3 = b2 + kstep;
            if (last && has_next) S.a_ready(nxt);
            if constexpr (SP2) {
            PG8_LDB(B0, 0, 0); PG8_LDB(B1, 0, 1); PG8_SCHED; PG8_LDA(At, 0, 0); PG8_STAGE(PG8_SA(1, 1), a1 + hstepA, voffA);
            PG8_WAIT_V(8); PG8_WAIT_L(0); PG8_BAR; PG8_MMA(0, 0, At, B0); PG8_MMA(0, 1, At, B1); PG8_BAR; PG8_SCHED;
            PG8_LDA(At, 0, 1); PG8_STAGE(PG8_SB(0, 0), b2, voffB); PG8_STAGE(PG8_SB(0, 1), b2 + hstepB, voffB); PG8_STAGE(PG8_SA(0, 0), a2, voffA);
            PG8_WAIT_V(8); PG8_WAIT_L(0); PG8_BAR; PG8_MMA(1, 0, At, B0); PG8_MMA(1, 1, At, B1); PG8_BAR; PG8_SCHED;
            PG8_LDB(B0, 1, 0); PG8_LDB(B1, 1, 1); PG8_SCHED; PG8_LDA(At, 1, 0); PG8_STAGE(PG8_SA(0, 1), a2 + hstepA, voffA);
            PG8_WAIT_V(8); PG8_WAIT_L(0); PG8_BAR; PG8_MMA(0, 0, At, B0); PG8_MMA(0, 1, At, B1); PG8_BAR; PG8_SCHED;
            PG8_LDA(At, 1, 1); PG8_STAGE(PG8_SB(1, 0), b3, voffB); PG8_STAGE(PG8_SB(1, 1), b3 + hstepB, voffB); PG8_STAGE(PG8_SA(1, 0), a3, voffA);
            PG8_WAIT_V(8); PG8_WAIT_L(0); PG8_BAR; PG8_MMA(1, 0, At, B0); PG8_MMA(1, 1, At, B1); PG8_BAR; PG8_SCHED;
            } else {
            PG8_LDB(B0, 0, 0); PG8_SCHED; PG8_LDA(At, 0, 0); PG8_STAGE(PG8_SA(1, 1), a1 + hstepA, voffA);
            PG8_WAIT_L(8); PG8_BAR; PG8_WAIT_L(0); PG8_MMA(0, 0, At, B0); PG8_BAR; PG8_SCHED;
            PG8_LDB(B1, 0, 1); PG8_STAGE(PG8_SB(0, 0), b2, voffB);
            PG8_BAR; PG8_WAIT_L(0); PG8_MMA(0, 1, At, B1); PG8_BAR;
            PG8_LDA(At, 0, 1); PG8_STAGE(PG8_SA(0, 0), a2, voffA);
            PG8_BAR; PG8_WAIT_L(0); PG8_MMA(1, 0, At, B0); PG8_BAR; PG8_SCHED;
            PG8_STAGE(PG8_SB(0, 1), b2 + hstepB, voffB);
            PG8_WAIT_V(6); PG8_BAR; PG8_MMA(1, 1, At, B1); PG8_BAR;
            PG8_LDB(B0, 1, 0); PG8_SCHED; PG8_LDA(At, 1, 0); PG8_STAGE(PG8_SA(0, 1), a2 + hstepA, voffA);
            PG8_WAIT_L(8); PG8_BAR; PG8_WAIT_L(0); PG8_MMA(0, 0, At, B0); PG8_BAR; PG8_SCHED;
            PG8_LDB(B1, 1, 1); PG8_STAGE(PG8_SB(1, 0), b3, voffB);
            PG8_BAR; PG8_WAIT_L(0); PG8_MMA(0, 1, At, B1); PG8_BAR;
            PG8_LDA(At, 1, 1); PG8_STAGE(PG8_SA(1, 0), a3, voffA);
            PG8_BAR; PG8_WAIT_L(0); PG8_MMA(1, 0, At, B0); PG8_BAR; PG8_SCHED;
            PG8_STAGE(PG8_SB(1, 1), b3 + hstepB, voffB);
            PG8_WAIT_V(6); PG8_BAR; PG8_MMA(1, 1, At, B1); PG8_BAR;
            }
        }
        if constexpr (ALIGN_EPI) { if (wr == 0) PG8_BAR; }
        if constexpr (!Epi::AFTER_DRAIN) { E(acc, cur, wr, wc, fr, fq); S.done(cur); }
        if (!has_next) break;
#pragma unroll
        for (int a = 0; a < 2; ++a)
#pragma unroll
            for (int b = 0; b < 2; ++b)
#pragma unroll
                for (int m = 0; m < 4; ++m)
#pragma unroll
                    for (int n = 0; n < 2; ++n) acc[a][b][m][n] = (f32x4){0.f, 0.f, 0.f, 0.f};
        cur = nxt; cA = nA; cB = nB; ++ui;
        if constexpr (ALIGN_EPI) { if (wr == 1) PG8_BAR; }
    }
    PG8_WAIT_V(0);
    if constexpr (!ALIGN_EPI) { if (wr == 0) PG8_BAR; }
    PG8_BAR;
#undef PG8_SA
#undef PG8_SB
#undef PG8_STAGE
#undef PG8_LDA
#undef PG8_LDB
#undef PG8_MMA
#undef PG8_WAIT_V
#undef PG8_WAIT_L
#undef PG8_BAR
#undef PG8_SCHED
}
}


#define XB_TMO      128
#define XB_XCNT(j)  (256  + 64 * (j))
#define XB_XSUB(j)  (1280 + 64 * (j))
#define XB_XGEN(j)  (2304 + 64 * (j))
#define XB_TOP      3328
#define XB_TOPGEN   3392
#define XCD_BAR_WORDS 3456
#define XB_SPIN_CAP (1u << 18)
#define LAS __attribute__((address_space(3)))
DEVI unsigned xb_ld(unsigned* p)              { return __hip_atomic_load(p, __ATOMIC_RELAXED, __HIP_MEMORY_SCOPE_AGENT); }
DEVI unsigned xb_add(unsigned* p, unsigned v) { return __hip_atomic_fetch_add(p, v, __ATOMIC_RELAXED, __HIP_MEMORY_SCOPE_AGENT); }
DEVI unsigned xb_xcc_id() { return (unsigned)__builtin_amdgcn_s_getreg((3 << 11) | 20) & 0xFu; }
#define XB_SPIN(cond, bar) do { unsigned _sp = 0; while (cond) { __builtin_amdgcn_s_sleep(1); \
    if ((++_sp & 255u) == 0u) { if (xb_ld(&(bar)[XB_TMO])) break; if (_sp > XB_SPIN_CAP) { atomicAdd(&(bar)[XB_TMO], 1u); break; } } } } while (0)
struct XcdBarrier { unsigned* bar; unsigned x; volatile LAS unsigned* st; };
DEVI XcdBarrier xcd_barrier_post(unsigned* bar, volatile LAS unsigned* st) {
    XcdBarrier b; b.bar = bar; b.x = xb_xcc_id(); b.st = st;
    if (threadIdx.x == 0) (void)xb_add(&bar[XB_XCNT(b.x)], 1u);
    return b;
}
DEVI void xcd_barrier_complete(unsigned* bar, unsigned x, unsigned& nloc, unsigned& nx) {
    const unsigned G = gridDim.x * gridDim.y * gridDim.z;
    unsigned sum, cnt, mine, sp = 0u;
    for (;;) {
        sum = 0u; cnt = 0u; mine = 0u;
#pragma unroll
        for (unsigned j = 0; j < 16; ++j) { const unsigned c = xb_ld(&bar[XB_XCNT(j)]); sum += c; cnt += (c > 0u) ? 1u : 0u; mine = (j == x) ? c : mine; }
        if (sum == G) break;
        __builtin_amdgcn_s_sleep(1);
        if ((++sp & 255u) == 0u) { if (xb_ld(&bar[XB_TMO])) break; if (sp > XB_SPIN_CAP) { atomicAdd(&bar[XB_TMO], 1u); break; } }
    }
    nloc = mine > 0u ? mine : 1u; nx = cnt > 0u ? cnt : 1u;
}
DEVI void xcd_barrier(const XcdBarrier& b) {
    asm volatile("s_waitcnt vmcnt(0)" ::: "memory");
    __syncthreads();
    if (threadIdx.x == 0) {
        unsigned* bar = b.bar;
        __builtin_amdgcn_s_waitcnt(0);
        unsigned nloc = b.st[0], nx = b.st[1];
        if (nloc == 0u) { xcd_barrier_complete(bar, b.x, nloc, nx); b.st[0] = nloc; b.st[1] = nx; }
        const unsigned old = xb_add(&bar[XB_XSUB(b.x)], 1u);
        const unsigned gen = old / nloc;
        if (old + 1u == (gen + 1u) * nloc) {
            __builtin_amdgcn_fence(__ATOMIC_RELEASE, "agent");
            asm volatile("s_waitcnt vmcnt(0)" ::: "memory");
            const unsigned og = xb_add(&bar[XB_TOP], 1u);
            const unsigned tg = og / nx;
            if (og + 1u == (tg + 1u) * nx) xb_add(&bar[XB_TOPGEN], 1u);
            else XB_SPIN(xb_ld(&bar[XB_TOPGEN]) == tg, bar);
            __builtin_amdgcn_fence(__ATOMIC_ACQUIRE, "agent");
            xb_add(&bar[XB_XGEN(b.x)], 1u);
            asm volatile("s_waitcnt vmcnt(0)" ::: "memory");
        } else {
            XB_SPIN(xb_ld(&bar[XB_XGEN(b.x)]) == gen, bar);
            __builtin_amdgcn_fence(__ATOMIC_ACQUIRE, "agent");
            asm volatile("s_waitcnt vmcnt(0)" ::: "memory");
        }
    }
    __syncthreads();
}

enum { MZ = 0, MVT, MQ, MK, MGATE, MY, MRES, MFFN, MPG, MPLE };
struct EpiGen {
    static constexpr bool PERM = false, AFTER_DRAIN = false;
    int mode, i0;
    const float* f0; const float* f1; const float* f2;
    bf16_t* b0; const bf16_t* b1;
    float* o0; float* o1; float* o2;
    DEVI void operator()(const f32x4 (&acc)[2][2][4][2], const pg8::Unit& u, int wr, int wc, int fr, int fq) const {
        const int rowb = u.pm * 256 + wr * 64 + fr, colb = u.pn * 256 + wc * 32 + 4 * fq;
        float rsv[2][4];
        if (mode == MZ || mode == MQ || mode == MK || mode == MGATE || mode == MPG || mode == MFFN) {
            const float dv = (mode == MQ) ? (1.f / 384.f) : (mode == MK) ? (1.f / 256.f) : (1.f / 1024.f); const float mult = (mode == MQ) ? QSCALE_MLA : 1.f;
            float raw[2][4];
#pragma unroll
            for (int ai = 0; ai < 2; ++ai)
#pragma unroll
                for (int m = 0; m < 4; ++m) raw[ai][m] = f0[rowb + ai * 128 + m * 16];
#pragma unroll
            for (int ai = 0; ai < 2; ++ai)
#pragma unroll
                for (int m = 0; m < 4; ++m) rsv[ai][m] = rsqrtf(raw[ai][m] * dv + EPS) * mult;
        }
        if (mode == MZ) {
            const int colp = u.pn * 256 + wc * 32 + 8 * fq;
            const int c0 = (u.pn == 4 || u.pn == 5) ? 1 : (u.pn == 6 ? 2 : 0);
            const int c1 = (u.pn == 4) ? 1 : (u.pn == 5 ? 2 : 0);
            const bool fl = (u.pn == 6 && wc == 1 && fq == 0);
            f32x4 bf0 = {0.f, 0.f, 0.f, 0.f}, bf1 = {0.f, 0.f, 0.f, 0.f}; if (fl) { bf0 = *(const f32x4*)(f1); bf1 = *(const f32x4*)(f1 + 4); }
#pragma unroll
            for (int ai = 0; ai < 2; ++ai)
#pragma unroll
                for (int m = 0; m < 4; ++m) {
                    const int row = rowb + ai * 128 + m * 16; const float rs = rsv[ai][m]; float sq[2] = {0.f, 0.f};
#pragma unroll
                    for (int bj = 0; bj < 2; ++bj) {
                        const f32x4 v0 = acc[ai][bj][m][0] * rs, v1 = acc[ai][bj][m][1] * rs;
                        u32x4 w; w.x = cvtpk(v0[0], v0[1]); w.y = cvtpk(v0[2], v0[3]); w.z = cvtpk(v1[0], v1[1]); w.w = cvtpk(v1[2], v1[3]);
                        *(u32x4*)(b0 + (size_t)row * NZ + colp + bj * 128) = w;
                        sq[bj] += ((v0[0] * v0[0] + v0[1] * v0[1]) + (v0[2] * v0[2] + v0[3] * v0[3])) + ((v1[0] * v1[0] + v1[1] * v1[1]) + (v1[2] * v1[2] + v1[3] * v1[3]));
                        if (fl && bj == 1) { f32x4 l0, l1;
                            l0[0] = logsig(v0[0] + bf0[0]); l0[1] = logsig(v0[1] + bf0[1]); l0[2] = logsig(v0[2] + bf0[2]); l0[3] = logsig(v0[3] + bf0[3]);
                            l1[0] = logsig(v1[0] + bf1[0]); l1[1] = logsig(v1[1] + bf1[1]); l1[2] = logsig(v1[2] + bf1[2]); l1[3] = logsig(v1[3] + bf1[3]);
                            *(f32x4*)(o0 + (size_t)row * 8) = l0; *(f32x4*)(o0 + (size_t)row * 8 + 4) = l1; }
                    }
                    if (c0 | c1) {
                        float s0 = sq[0], s1 = sq[1];
                        s0 += __shfl_xor(s0, 16); s0 += __shfl_xor(s0, 32); s1 += __shfl_xor(s1, 16); s1 += __shfl_xor(s1, 32);
                        if (fq == 0) {
                            if (c0 == 1) unsafeAtomicAdd(o1 + row, s0); else if (c0 == 2) unsafeAtomicAdd(o2 + row, s0);
                            if (c1 == 1) unsafeAtomicAdd(o1 + row, s1); else if (c1 == 2) unsafeAtomicAdd(o2 + row, s1);
                        }
                    }
                }
        } else if (mode == MVT) {
            const int colp = u.pn * 256 + wc * 32 + 8 * fq; const float dv = i0 ? (1.f / 256.f) : (1.f / 1024.f);
            f32x4 scv[2][2];
#pragma unroll
            for (int bj = 0; bj < 2; ++bj)
#pragma unroll
                for (int n = 0; n < 2; ++n) scv[bj][n] = *(const f32x4*)(f0 + colp + bj * 128 + 4 * n);
#pragma unroll
            for (int bj = 0; bj < 2; ++bj) {
                f32x4 s0 = scv[bj][0], s1 = scv[bj][1];
#pragma unroll
                for (int e = 0; e < 4; ++e) { s0[e] = rsqrtf(s0[e] * dv + EPS); s1[e] = rsqrtf(s1[e] * dv + EPS); }
                const int col = colp + bj * 128, bb = col >> 13, sx = col & 8191;
#pragma unroll
                for (int ai = 0; ai < 2; ++ai)
#pragma unroll
                    for (int m = 0; m < 4; ++m) {
                        const int row = rowb + ai * 128 + m * 16; const f32x4 v0 = acc[ai][bj][m][0] * s0, v1 = acc[ai][bj][m][1] * s1;
                        u32x4 w; w.x = cvtpk(v0[0], v0[1]); w.y = cvtpk(v0[2], v0[3]); w.z = cvtpk(v1[0], v1[1]); w.w = cvtpk(v1[2], v1[3]);
                        *(u32x4*)(b0 + ((size_t)(bb * 512 + row)) * S_ + sx) = w;
                    }
            }
        } else if (mode == MQ) {
            const bool anyrope = ((u.pn * 8 + wc) % 3 == 2) || ((u.pn * 8 + 4 + wc) % 3 == 2);
#pragma unroll
            for (int ai = 0; ai < 2; ++ai) {
                f32x4 cs[4], sn[4];
#pragma unroll
                for (int m = 0; m < 4; ++m) { const int pos = (rowb + ai * 128 + m * 16) & 8191;
                    if (anyrope) { cs[m] = *(const f32x4*)(f1 + pos * 16 + 4 * fq); sn[m] = *(const f32x4*)(f2 + pos * 16 + 4 * fq); } else { cs[m] = (f32x4){1.f, 1.f, 1.f, 1.f}; sn[m] = (f32x4){0.f, 0.f, 0.f, 0.f}; } }
#pragma unroll
                for (int m = 0; m < 4; ++m) {
                    const int row = rowb + ai * 128 + m * 16; const float rs = rsv[ai][m];
#pragma unroll
                    for (int bj = 0; bj < 2; ++bj) {
                        const int g32 = u.pn * 8 + bj * 4 + wc;
                        f32x4 x1 = acc[ai][bj][m][0] * rs, x2 = acc[ai][bj][m][1] * rs;
                        if (g32 % 3 == 2) { const f32x4 c = cs[m], s_ = sn[m]; const f32x4 y1 = x1 * c - x2 * s_, y2 = x2 * c + x1 * s_; x1 = y1; x2 = y2; }
                        const int col = colb + bj * 128;
                        u32x2 w; w.x = cvtpk(x1[0], x1[1]); w.y = cvtpk(x1[2], x1[3]); *(u32x2*)(b0 + (size_t)row * 768 + col) = w;
                        w.x = cvtpk(x2[0], x2[1]); w.y = cvtpk(x2[2], x2[3]); *(u32x2*)(b0 + (size_t)row * 768 + col + 16) = w;
                    }
                }
                asm volatile("" ::: "memory");
            }
        } else if (mode == MK) {
            const int colp = u.pn * 256 + wc * 32 + 8 * fq;
#pragma unroll
            for (int ai = 0; ai < 2; ++ai)
#pragma unroll
                for (int m = 0; m < 4; ++m) {
                    const int row = rowb + ai * 128 + m * 16; const float rs = rsv[ai][m];
#pragma unroll
                    for (int bj = 0; bj < 2; ++bj) {
                        const int col = colp + bj * 128; const f32x4 v0 = acc[ai][bj][m][0] * rs, v1 = acc[ai][bj][m][1] * rs;
                        u32x4 w; w.x = cvtpk(v0[0], v0[1]); w.y = cvtpk(v0[2], v0[3]); w.z = cvtpk(v1[0], v1[1]); w.w = cvtpk(v1[2], v1[3]);
                        *(u32x4*)(b0 + (size_t)row * 768 + (col >> 6) * 96 + (col & 63)) = w;
                    }
                }
        } else if (mode == MGATE) {
            const int colp = u.pn * 256 + wc * 32 + 8 * fq;
            f32x4 bvp[2][2];
#pragma unroll
            for (int bj = 0; bj < 2; ++bj)
#pragma unroll
                for (int n = 0; n < 2; ++n) bvp[bj][n] = *(const f32x4*)(f1 + colp + bj * 128 + 4 * n);
#pragma unroll
            for (int ai = 0; ai < 2; ++ai)
#pragma unroll
                for (int m = 0; m < 4; ++m) {
                    const int row = rowb + ai * 128 + m * 16; const float rs = rsv[ai][m];
#pragma unroll
                    for (int bj = 0; bj < 2; ++bj) {
                        const f32x4 v0 = acc[ai][bj][m][0] * rs + bvp[bj][0], v1 = acc[ai][bj][m][1] * rs + bvp[bj][1];
                        u32x4 w; w.x = cvtpk(sigm(v0[0]), sigm(v0[1])); w.y = cvtpk(sigm(v0[2]), sigm(v0[3])); w.z = cvtpk(sigm(v1[0]), sigm(v1[1])); w.w = cvtpk(sigm(v1[2]), sigm(v1[3]));
                        *(u32x4*)(b0 + (size_t)row * 1024 + colp + bj * 128) = w;
                    }
                }
        } else if (mode == MPG) {
            const int colp = u.pn * 256 + wc * 32 + 8 * fq;
#pragma unroll
            for (int ai = 0; ai < 2; ++ai)
#pragma unroll
                for (int m = 0; m < 4; ++m) {
                    const int row = rowb + ai * 128 + m * 16; const float rs = rsv[ai][m];
#pragma unroll
                    for (int bj = 0; bj < 2; ++bj) {
                        const f32x4 v0 = acc[ai][bj][m][0] * rs, v1 = acc[ai][bj][m][1] * rs;
                        u32x4 w; w.x = cvtpk(sigm(v0[0]), sigm(v0[1])); w.y = cvtpk(sigm(v0[2]), sigm(v0[3])); w.z = cvtpk(sigm(v1[0]), sigm(v1[1])); w.w = cvtpk(sigm(v1[2]), sigm(v1[3]));
                        *(u32x4*)(b0 + (size_t)row * 1024 + colp + bj * 128) = w;
                    }
                }
        } else if (mode == MY) {
            const int colp = u.pn * 256 + wc * 32 + 8 * fq;
#pragma unroll
            for (int ai = 0; ai < 2; ++ai) {
                u32x4 gw[4][2], ow[4][2];
#pragma unroll
                for (int m = 0; m < 4; ++m)
#pragma unroll
                    for (int bj = 0; bj < 2; ++bj) {
                        const size_t ix = (size_t)(rowb + ai * 128 + m * 16) * 1024 + colp + bj * 128;
                        gw[m][bj] = *(const u32x4*)(b1 + ix); if (!i0) ow[m][bj] = *(const u32x4*)(b0 + ix); else ow[m][bj] = (u32x4){0u, 0u, 0u, 0u};
                    }
#pragma unroll
                for (int m = 0; m < 4; ++m)
#pragma unroll
                    for (int bj = 0; bj < 2; ++bj) {
                        const size_t ix = (size_t)(rowb + ai * 128 + m * 16) * 1024 + colp + bj * 128;
                        const u32x4 g4 = gw[m][bj], o4 = ow[m][bj]; const f32x4 a0 = acc[ai][bj][m][0], a1 = acc[ai][bj][m][1];
                        u32x4 w;
                        w.x = cvtpk(bflo(g4.x) * a0[0] + bflo(o4.x), bfhi(g4.x) * a0[1] + bfhi(o4.x)); w.y = cvtpk(bflo(g4.y) * a0[2] + bflo(o4.y), bfhi(g4.y) * a0[3] + bfhi(o4.y));
                        w.z = cvtpk(bflo(g4.z) * a1[0] + bflo(o4.z), bfhi(g4.z) * a1[1] + bfhi(o4.z)); w.w = cvtpk(bflo(g4.w) * a1[2] + bflo(o4.w), bfhi(g4.w) * a1[3] + bfhi(o4.w));
                        *(u32x4*)(b0 + ix) = w;
                    }
            }
        } else if (mode == MRES || mode == MPLE) {
            const int colp = u.pn * 256 + wc * 32 + 8 * fq;
#pragma unroll
            for (int ai = 0; ai < 2; ++ai)
#pragma unroll
                for (int mh = 0; mh < 2; ++mh) {
                    f32x4 bs[2][2][2]; u32x4 gw[2][2];
#pragma unroll
                    for (int mm = 0; mm < 2; ++mm)
#pragma unroll
                        for (int bj = 0; bj < 2; ++bj) {
                            const size_t ix = (size_t)(rowb + ai * 128 + (2 * mh + mm) * 16) * 1024 + colp + bj * 128;
                            bs[mm][bj][0] = *(const f32x4*)(f0 + ix); bs[mm][bj][1] = *(const f32x4*)(f0 + ix + 4);
                            if (mode == MPLE) gw[mm][bj] = *(const u32x4*)(b1 + ix); else gw[mm][bj] = (u32x4){0u, 0u, 0u, 0u};
                        }
#pragma unroll
                    for (int mm = 0; mm < 2; ++mm) {
                        const int m = 2 * mh + mm, row = rowb + ai * 128 + m * 16; float sq = 0.f;
#pragma unroll
                        for (int bj = 0; bj < 2; ++bj) {
                            const size_t ix = (size_t)row * 1024 + colp + bj * 128;
                            f32x4 a0 = acc[ai][bj][m][0], a1 = acc[ai][bj][m][1];
                            if (mode == MPLE) { const u32x4 g4 = gw[mm][bj]; a0[0] *= bflo(g4.x); a0[1] *= bfhi(g4.x); a0[2] *= bflo(g4.y); a0[3] *= bfhi(g4.y); a1[0] *= bflo(g4.z); a1[1] *= bfhi(g4.z); a1[2] *= bflo(g4.w); a1[3] *= bfhi(g4.w); }
                            const f32x4 r0 = bs[mm][bj][0] + a0, r1 = bs[mm][bj][1] + a1; *(f32x4*)(o0 + ix) = r0; *(f32x4*)(o0 + ix + 4) = r1;
                            if (b0) { u32x4 w; w.x = cvtpk(r0[0], r0[1]); w.y = cvtpk(r0[2], r0[3]); w.z = cvtpk(r1[0], r1[1]); w.w = cvtpk(r1[2], r1[3]); *(u32x4*)(b0 + ix) = w; }
                            sq += ((r0[0] * r0[0] + r0[1] * r0[1]) + (r0[2] * r0[2] + r0[3] * r0[3])) + ((r1[0] * r1[0] + r1[1] * r1[1]) + (r1[2] * r1[2] + r1[3] * r1[3]));
                        }
                        sq += __shfl_xor(sq, 16); sq += __shfl_xor(sq, 32);
                        if (fq == 0) unsafeAtomicAdd(o1 + row, sq);
                    }
                    asm volatile("" ::: "memory");
                }
        } else if (mode == MFFN) {
            const int colo = u.pn * 128 + wc * 32 + 8 * fq;
#pragma unroll
            for (int ai = 0; ai < 2; ++ai)
#pragma unroll
                for (int m = 0; m < 4; ++m) {
                    const int row = rowb + ai * 128 + m * 16; const float rs = rsv[ai][m];
                    const f32x4 g0 = acc[ai][0][m][0] * rs, g1 = acc[ai][0][m][1] * rs, u0 = acc[ai][1][m][0] * rs, u1 = acc[ai][1][m][1] * rs;
                    u32x4 w; w.x = cvtpk(g0[0] * sigm(g0[0]) * u0[0], g0[1] * sigm(g0[1]) * u0[1]); w.y = cvtpk(g0[2] * sigm(g0[2]) * u0[2], g0[3] * sigm(g0[3]) * u0[3]);
                    w.z = cvtpk(g1[0] * sigm(g1[0]) * u1[0], g1[1] * sigm(g1[1]) * u1[1]); w.w = cvtpk(g1[2] * sigm(g1[2]) * u1[2], g1[3] * sigm(g1[3]) * u1[3]);
                    *(u32x4*)(b0 + (size_t)row * 2816 + colo) = w;
                }
        }
    }
};

constexpr size_t W_IN = 0;
constexpr size_t W_V  = W_IN + 2816ull * 1024;
constexpr size_t W_G  = W_V + 512ull * 1024;
constexpr size_t W_UQ = W_G + 3072ull * 1024;
constexpr size_t W_UK = W_UQ + 768ull * 384;
constexpr size_t W_UV = W_UK + 512ull * 256;
constexpr size_t W_BA = W_UV + 512ull * 256;
constexpr size_t W_BB = W_BA + 1024ull * 512;
constexpr size_t W_BC = W_BB + 1024ull * 512;
constexpr size_t W_O  = W_BC + 1024ull * 512;
constexpr size_t W_GU = W_O + 1024ull * 1024;
constexpr size_t W_DN = W_GU + 5632ull * 1024;
constexpr size_t W_PG = W_DN + 1024ull * 2816;
constexpr size_t W_PL = W_PG + 1024ull * 1024;
constexpr size_t W_LA = W_PL + 1024ull * 256;
constexpr size_t W_LX = W_LA + 512ull * 64;
constexpr size_t W_LAYER = W_LX + 512ull * 64;
constexpr size_t MiB = 1ull << 20;
constexpr size_t WS_W = 0, WS_XB = 76 * MiB, WS_ZB = 140 * MiB, WS_FVT = 316 * MiB, WS_QM = 348 * MiB, WS_KM = 396 * MiB, WS_VTM = 444 * MiB;
constexpr size_t WS_GS = 348 * MiB, WS_MG = 412 * MiB, WS_PB = 484 * MiB;
constexpr size_t WS_SM = 476 * MiB;
constexpr size_t SM_SSQA = WS_SM, SM_SSQQ = SM_SSQA + 131072, SM_SSQKV = SM_SSQQ + 131072, SM_FLOG = SM_SSQKV + 131072, SM_KBIAS = SM_FLOG + MiB,
                 SM_AGGP = SM_KBIAS + MiB, SM_AGGH = SM_AGGP + 524288, SM_TCOS = SM_AGGH + 524288, SM_TSIN = SM_TCOS + 524288, SM_SSQB = SM_TSIN + 524288, SM_SSQC = SM_SSQB + 131072,
                 SM_BAR = SM_SSQC + 131072, WS_END = 500 * MiB;
static_assert(SM_BAR + 16384 <= WS_PB, "small region");
static_assert(2 * W_LAYER * 2 <= 76 * MiB, "weights");
constexpr int LDS_GEMM = pg8::STAGE_BYTES;
constexpr int LDS_BYTES = LDS_GEMM + 16;

struct Params { const float* in[28]; float* out; unsigned char* ws; int ph_lo, ph_hi; };

enum { CM_ID = 0, CM_WIN, CM_KVK, CM_KVV, CM_GU, CM_LRU };
template <int CM> DEVI void prep_w(unsigned char* smem, bf16_t* dst, int N, int K, const float* __restrict__ src, int ld, int coloff, const float* __restrict__ ks, int G) {
    bf16_t* tile = (bf16_t*)smem;
    const int tid = otid(), nl = tid & 63, k8 = tid >> 6, sn = tid >> 3, sk = tid & 7;
    const int ntn = N >> 6, ntiles = ntn * (K >> 6);
    for (int tl = blockIdx.x; tl < ntiles; tl += G) {
        const int n0 = (tl % ntn) << 6, k0 = (tl / ntn) << 6, n = n0 + nl;
        int sc = 0; float ns = 1.f; bool zero = false;
        if (CM == CM_ID) sc = coloff + n;
        else if (CM == CM_WIN) {
            if (n < 1696) sc = n; else if (n < 1704) sc = 3232 + (n - 1696); else if (n < 1792) zero = true;
            else if (n < 2304) { sc = 1696 + (n - 1792); ns = QSCALE_FOX; } else sc = 2208 + (n - 2304);
        } else if (CM == CM_KVK) sc = (n >> 6) * 128 + (n & 63);
        else if (CM == CM_KVV) sc = (n >> 6) * 128 + 64 + (n & 63);
        else if (CM == CM_GU) { const int tq = n >> 8, wq = n & 255; sc = (wq < 128) ? (128 * tq + wq) : (2816 + 128 * tq + (wq - 128)); }
        else sc = (n >> 6) * 4096 + (n & 63);
        float v[8];
#pragma unroll
        for (int i = 0; i < 8; ++i) { const int k = k0 + k8 + 8 * i; v[i] = zero ? 0.f : src[(size_t)k * ld + sc] * (ks ? ks[k] : 1.f) * ns; }
#pragma unroll
        for (int i = 0; i < 8; ++i) tile[nl * 72 + k8 + 8 * i] = f2bf(v[i]);
        __syncthreads();
        *(u32x4*)(dst + (size_t)(n0 + sn) * K + k0 + 8 * sk) = *(const u32x4*)(tile + sn * 72 + 8 * sk);
        __syncthreads();
    }
}

struct PrepDesc { bf16_t* dst; const float* src; const float* ks; int N, K, ld, coloff, cm; };
DEVI void prep_desc(const Params& P, bf16_t* WB, int g, PrepDesc& d, int& tl) {
    const int L = g / 4824, r = g % 4824; bf16_t* W = WB + (size_t)L * W_LAYER;
    const float* w_in = P.in[3] + (size_t)L * 1024 * 6312; const float* gmix = P.in[2] + L * 1024;
    if (r < 704)       { d = PrepDesc{W + W_IN, w_in, gmix, 2816, 1024, 6312, 0, CM_WIN}; tl = r; }
    else if (r < 832)  { d = PrepDesc{W + W_V, w_in, gmix, 512, 1024, 6312, 2720, CM_ID}; tl = r - 704; }
    else if (r < 1600) { d = PrepDesc{W + W_G, w_in, gmix, 3072, 1024, 6312, 3240, CM_ID}; tl = r - 832; }
    else if (r < 1672) { d = PrepDesc{W + W_UQ, P.in[13] + (size_t)L * 384 * 768, P.in[12] + L * 384, 768, 384, 768, 0, CM_ID}; tl = r - 1600; }
    else if (r < 1704) { d = PrepDesc{W + W_UK, P.in[15] + (size_t)L * 256 * 1024, P.in[14] + L * 256, 512, 256, 1024, 0, CM_KVK}; tl = r - 1672; }
    else if (r < 1736) { d = PrepDesc{W + W_UV, P.in[15] + (size_t)L * 256 * 1024, P.in[14] + L * 256, 512, 256, 1024, 0, CM_KVV}; tl = r - 1704; }
    else if (r < 1864) { d = PrepDesc{W + W_BA, P.in[17] + (size_t)L * 512 * 1024, nullptr, 1024, 512, 1024, 0, CM_ID}; tl = r - 1736; }
    else if (r < 1992) { d = PrepDesc{W + W_BB, P.in[18] + (size_t)L * 512 * 1024, nullptr, 1024, 512, 1024, 0, CM_ID}; tl = r - 1864; }
    else if (r < 2120) { d = PrepDesc{W + W_BC, P.in[19] + (size_t)L * 512 * 1024, nullptr, 1024, 512, 1024, 0, CM_ID}; tl = r - 1992; }
    else if (r < 2376) { d = PrepDesc{W + W_O, P.in[20] + (size_t)L * 1024 * 1024, nullptr, 1024, 1024, 1024, 0, CM_ID}; tl = r - 2120; }
    else if (r < 3784) { d = PrepDesc{W + W_GU, P.in[22] + (size_t)L * 1024 * 5632, P.in[21] + L * 1024, 5632, 1024, 5632, 0, CM_GU}; tl = r - 2376; }
    else if (r < 4488) { d = PrepDesc{W + W_DN, P.in[23] + (size_t)L * 2816 * 1024, nullptr, 1024, 2816, 1024, 0, CM_ID}; tl = r - 3784; }
    else if (r < 4744) { d = PrepDesc{W + W_PG, P.in[25] + (size_t)L * 1024 * 1024, P.in[24] + L * 1024, 1024, 1024, 1024, 0, CM_ID}; tl = r - 4488; }
    else if (r < 4808) { d = PrepDesc{W + W_PL, P.in[26] + (size_t)L * 256 * 1024, nullptr, 1024, 256, 1024, 0, CM_ID}; tl = r - 4744; }
    else if (r < 4816) { d = PrepDesc{W + W_LA, P.in[7] + (size_t)L * 32768, nullptr, 512, 64, 64, 0, CM_LRU}; tl = r - 4808; }
    else               { d = PrepDesc{W + W_LX, P.in[9] + (size_t)L * 32768, nullptr, 512, 64, 64, 0, CM_LRU}; tl = r - 4816; }
}
DEVI void prep_tile_load(const PrepDesc& d, int tl, int nl, int k8, float (&v)[8], int& n0, int& k0) {
    const int ntn = d.N >> 6; n0 = (tl % ntn) << 6; k0 = (tl / ntn) << 6; const int n = n0 + nl;
    int sc = 0; float ns = 1.f; bool zero = false;
    if (d.cm == CM_ID) sc = d.coloff + n;
    else if (d.cm == CM_WIN) {
        if (n < 1696) sc = n; else if (n < 1704) sc = 3232 + (n - 1696); else if (n < 1792) zero = true;
        else if (n < 2304) { sc = 1696 + (n - 1792); ns = QSCALE_FOX; } else sc = 2208 + (n - 2304);
    } else if (d.cm == CM_KVK) sc = (n >> 6) * 128 + (n & 63);
    else if (d.cm == CM_KVV) sc = (n >> 6) * 128 + 64 + (n & 63);
    else if (d.cm == CM_GU) { const int tq = n >> 8, wq = n & 255; sc = (wq < 128) ? (128 * tq + wq) : (2816 + 128 * tq + (wq - 128)); }
    else sc = (n >> 6) * 4096 + (n & 63);
#pragma unroll
    for (int i = 0; i < 8; ++i) { const int k = k0 + k8 + 8 * i; v[i] = zero ? 0.f : d.src[(size_t)k * d.ld + sc] * (d.ks ? d.ks[k] : 1.f) * ns; }
}
DEVI void prep_all(unsigned char* smem, const Params& P, bf16_t* WB, int G) {
    bf16_t* tile = (bf16_t*)smem;
    const int tid = otid(), nl = tid & 63, k8 = tid >> 6, sn = tid >> 3, sk = tid & 7;
    constexpr int NTILE = 2 * 4824;
    for (int g = 4 * blockIdx.x; g < NTILE; g += 4 * G) {
        PrepDesc d[4]; int tl[4], n0[4], k0[4]; float v[4][8];
#pragma unroll
        for (int j = 0; j < 4; ++j) { prep_desc(P, WB, g + j, d[j], tl[j]); prep_tile_load(d[j], tl[j], nl, k8, v[j], n0[j], k0[j]); }
#pragma unroll
        for (int j = 0; j < 4; ++j)
#pragma unroll
            for (int i = 0; i < 8; ++i) tile[j * 64 * 72 + nl * 72 + k8 + 8 * i] = f2bf(v[j][i]);
        __syncthreads();
#pragma unroll
        for (int j = 0; j < 4; ++j) *(u32x4*)(d[j].dst + (size_t)(n0[j] + sn) * d[j].K + k0[j] + 8 * sk) = *(const u32x4*)(tile + j * 64 * 72 + sn * 72 + 8 * sk);
        __syncthreads();
    }
}

DEVI void rope_table(float* tcos, float* tsin, int gtid, int gsz) {
    for (int it = gtid; it < 8192 * 16; it += gsz) {
        const int pos = it >> 4, i = it & 15, j = i & 3, k = i >> 2;
        const double bj = (j == 0) ? 1.0 : (j == 1) ? 0.5623413251903491 : (j == 2) ? 0.31622776601683794 : 0.1778279410038923;
        const double pk = (k == 0) ? 1.0 : (k == 1) ? 0.1 : (k == 2) ? 0.01 : 0.001;
        const float inv = (float)(bj * pk);
        const float ang = __fmul_rn((float)pos, inv);
        const double a = (double)ang; const double kk = rint(a * 0.15915494309189535); const double r = a - kk * 6.283185307179586476925;
        const double r2 = r * r; double sn = 0.0, cs = 0.0;
        double ts = 1.0, tc = 1.0;
#pragma unroll 1
        for (int n = 13; n >= 1; --n) { ts = 1.0 - ts * r2 / (double)((2 * n) * (2 * n + 1)); tc = 1.0 - tc * r2 / (double)((2 * n - 1) * (2 * n)); }
        sn = r * ts; cs = tc;
        tcos[it] = (float)cs; tsin[it] = (float)sn;
    }
}

DEVI void rownorm_phase(const float* __restrict__ x, bf16_t* xb, float* rstd, int G) {
    const int tid_ = otid(); const int lane = tid_ & 63, gw = blockIdx.x * 8 + (tid_ >> 6), nw = G * 8;
    for (int row = gw; row < T_; row += nw) {
        const f32x4* xr = (const f32x4*)(x + (size_t)row * 1024); f32x4 v[4]; float ss = 0.f;
#pragma unroll
        for (int i = 0; i < 4; ++i) { v[i] = xr[lane + 64 * i]; ss += (v[i][0] * v[i][0] + v[i][1] * v[i][1]) + (v[i][2] * v[i][2] + v[i][3] * v[i][3]); }
#pragma unroll
        for (int o = 32; o; o >>= 1) ss += __shfl_xor(ss, o);
        if (lane == 0) rstd[row] = ss;
#pragma unroll
        for (int i = 0; i < 4; ++i) { u32x2 w; w.x = cvtpk(v[i][0], v[i][1]); w.y = cvtpk(v[i][2], v[i][3]); *(u32x2*)(xb + (size_t)row * 1024 + (lane + 64 * i) * 4) = w; }
    }
}
DEVI void finalnorm_phase(float* x, const float* __restrict__ g, const float* __restrict__ ssq, int G) {
    const int tid_ = otid(); const int lane = tid_ & 63, gw = blockIdx.x * 8 + (tid_ >> 6), nw = G * 8;
    for (int row = gw; row < T_; row += nw) {
        f32x4* xr = (f32x4*)(x + (size_t)row * 1024); const float rs = rsqrtf(ssq[row] * (1.f / 1024.f) + EPS);
#pragma unroll
        for (int i = 0; i < 4; ++i) { const f32x4 gv = ((const f32x4*)g)[lane + 64 * i]; const f32x4 xv = __builtin_nontemporal_load(xr + lane + 64 * i); __builtin_nontemporal_store(xv * rs * gv, xr + lane + 64 * i); }
    }
}

DEVI void krope_fill(const bf16_t* __restrict__ zb, bf16_t* km, const float* __restrict__ tcos, const float* __restrict__ tsin, int gtid, int gsz) {
    for (int it = gtid; it < T_ * 8; it += gsz) {
        const int t = it >> 3, h = it & 7, pos = t & 8191;
        const u32x4* src = (const u32x4*)(zb + (size_t)t * NZ + 1664); u32x4 q[4];
#pragma unroll
        for (int i = 0; i < 4; ++i) q[i] = src[i];
        float x[32];
#pragma unroll
        for (int i = 0; i < 4; ++i) { x[8 * i] = bflo(q[i].x); x[8 * i + 1] = bfhi(q[i].x); x[8 * i + 2] = bflo(q[i].y); x[8 * i + 3] = bfhi(q[i].y); x[8 * i + 4] = bflo(q[i].z); x[8 * i + 5] = bfhi(q[i].z); x[8 * i + 6] = bflo(q[i].w); x[8 * i + 7] = bfhi(q[i].w); }
        float y[32];
#pragma unroll
        for (int i4 = 0; i4 < 4; ++i4) {
            const f32x4 c = *(const f32x4*)(tcos + pos * 16 + 4 * i4), s = *(const f32x4*)(tsin + pos * 16 + 4 * i4);
#pragma unroll
            for (int e = 0; e < 4; ++e) { const int i = 4 * i4 + e; y[i] = x[i] * c[e] - x[16 + i] * s[e]; y[16 + i] = x[16 + i] * c[e] + x[i] * s[e]; }
        }
        u32x4* dst = (u32x4*)(km + (size_t)t * 768 + h * 96 + 64);
#pragma unroll
        for (int i = 0; i < 4; ++i) { u32x4 w; w.x = cvtpk(y[8 * i], y[8 * i + 1]); w.y = cvtpk(y[8 * i + 2], y[8 * i + 3]); w.z = cvtpk(y[8 * i + 4], y[8 * i + 5]); w.w = cvtpk(y[8 * i + 6], y[8 * i + 7]); dst[i] = w; }
    }
}
DEVI void fox_cumsum(unsigned char* smem, const float* __restrict__ flog, float* kbias, int G) {
    const int tid_ = otid(); const int lane = tid_ & 63, w = tid_ >> 6;
    double* tot = (double*)smem;
    for (int u = blockIdx.x; u < 32; u += G) {
        const int b = u >> 3, h = u & 7; const int s0 = 1024 * w + 16 * lane;
        const float* fp = flog + ((size_t)b * S_ + s0) * 8 + h;
        float v[16];
#pragma unroll
        for (int i = 0; i < 16; ++i) v[i] = fp[i * 8];
        double c[16]; double run = 0.0;
#pragma unroll
        for (int i = 0; i < 16; ++i) { run += (double)v[i]; c[i] = run; }
        double incl = run;
#pragma unroll
        for (int o = 1; o < 64; o <<= 1) { const double t = __shfl_up(incl, o); if (lane >= o) incl += t; }
        if (lane == 63) tot[w] = incl;
        __syncthreads();
        double base = incl - run;
        for (int k = 0; k < w; ++k) base += tot[k];
        f32x4* kp = (f32x4*)(kbias + ((size_t)(b * 8 + h)) * S_ + s0);
#pragma unroll
        for (int i = 0; i < 4; ++i) { f32x4 o; o[0] = (float)(-(base + c[4 * i]) * 1.4426950408889634); o[1] = (float)(-(base + c[4 * i + 1]) * 1.4426950408889634);
            o[2] = (float)(-(base + c[4 * i + 2]) * 1.4426950408889634); o[3] = (float)(-(base + c[4 * i + 3]) * 1.4426950408889634); kp[i] = o; }
        __syncthreads();
    }
}

DEVI f32x16 mfma32(bf16x8 a, bf16x8 b, f32x16 c) { return __builtin_amdgcn_mfma_f32_32x32x16_bf16(a, b, c, 0, 0, 0); }
DEVI float gelu_tanh(float x) { const float y = 0.7978845608028654f * (x + 0.044715f * x * x * x); const float t = 1.f - 2.f * __builtin_amdgcn_rcpf(1.f + __builtin_amdgcn_exp2f(2.8853900817779268f * y)); return 0.5f * x * (1.f + t); }

template <bool PASS2>
DEVI void lru_unit(unsigned char* smem, bf16_t* zb, const bf16_t* __restrict__ waT, const bf16_t* __restrict__ wxT, const float* __restrict__ conv_w, const float* __restrict__ conv_b,
                   const float* __restrict__ ba, const float* __restrict__ bx, const float* __restrict__ lam, float* aggP, float* aggH, int b, int ch) {
    const int tid = otid(), lane = tid & 63, r32 = lane & 31, hi = lane >> 5, hh = tid >> 6;
    bf16_t* xa = (bf16_t*)(smem + hh * 12800);
    float* xcs = (float*)(smem + hh * 12800 + 4608);
    const unsigned cL = 64 * hh + lane;
    const float cw0 = conv_w[cL], cw1 = conv_w[512 + cL], cw2 = conv_w[1024 + cL], cw3 = conv_w[1536 + cL], cb = conv_b[cL];
    const unsigned cC = 64 * hh + r32;
    const float bav0 = ba[cC], bav1 = ba[cC + 32], bxv0 = bx[cC], bxv1 = bx[cC + 32];
    const float sp80 = 8.f * log1pf(expf(-lam[cC])), sp81 = 8.f * log1pf(expf(-lam[cC + 32]));
    const unsigned tb = (unsigned)b * S_ + (unsigned)ch * 128;
    float um3 = 0.f, um2 = 0.f, um1 = 0.f;
    if (ch > 0) { um3 = bf2f(zb[(tb - 3) * NZ + cL]); um2 = bf2f(zb[(tb - 2) * NZ + cL]); um1 = bf2f(zb[(tb - 1) * NZ + cL]); }
    float hc0 = 0.f, hc1 = 0.f, Pt0 = 1.f, Pt1 = 1.f;
    if (PASS2) {
        const unsigned ab = (unsigned)b * 64 * 512 + cC;
#pragma unroll 8
        for (int k = 0; k < ch; ++k) { hc0 = aggP[ab + k * 512] * hc0 + aggH[ab + k * 512]; hc1 = aggP[ab + k * 512 + 32] * hc1 + aggH[ab + k * 512 + 32]; }
    }
#pragma nounroll
    for (int sb = 0; sb < 4; ++sb) {
        const unsigned t0 = tb + 32 * sb;
#pragma unroll
        for (int i0 = 0; i0 < 32; i0 += 16) {
            float uu[16];
#pragma unroll
            for (int i = 0; i < 16; ++i) uu[i] = bf2f(zb[(t0 + i0 + i) * NZ + cL]);
#pragma unroll
            for (int i = 0; i < 16; ++i) {
                const float xc = cb + cw0 * um3 + cw1 * um2 + cw2 * um1 + cw3 * uu[i]; um3 = um2; um2 = um1; um1 = uu[i];
                xcs[(i0 + i) * 64 + lane] = xc; xa[(i0 + i) * 72 + lane] = f2bf(xc);
            }
        }
        bf16x8 af[4];
#pragma unroll
        for (int s = 0; s < 4; ++s) af[s] = *(const bf16x8*)(xa + r32 * 72 + 16 * s + 8 * hi);
#pragma nounroll
        for (int jh = 0; jh < 2; ++jh) {
            const float bavj = jh ? bav1 : bav0, bxvj = jh ? bxv1 : bxv0, sp8j = jh ? sp81 : sp80;
            f32x16 ca = {}, cx = {};
            { const unsigned wo = (cC + 32 * jh) * 64 + 8 * hi;
#pragma unroll
              for (int s = 0; s < 4; ++s) { const bf16x8 wa_ = *(const bf16x8*)(waT + wo + 16 * s), wx_ = *(const bf16x8*)(wxT + wo + 16 * s); ca = mfma32(af[s], wa_, ca); cx = mfma32(af[s], wx_, cx); } }
            float av[16], bv[16];
            const float* xcp = xcs + 4 * hi * 64 + r32 + 32 * jh;
#pragma unroll
            for (int r = 0; r < 16; ++r) {
                const float xc = xcp[((r & 3) + 8 * (r >> 2)) * 64];
                const float rg = sigm(ca[r] + bavj), ig = sigm(cx[r] + bxvj); const float la = -sp8j * rg;
                av[r] = __expf(la); bv[r] = __builtin_amdgcn_sqrtf(fmaxf(1.f - av[r] * av[r], 0.f)) * ig * xc;
            }
            float A[4], B[4], pA[4], pB[4], hs[4];
#pragma unroll
            for (int g = 0; g < 4; ++g) { float a_ = 1.f, b_ = 0.f;
#pragma unroll
                for (int e = 0; e < 4; ++e) { b_ = av[4 * g + e] * b_ + bv[4 * g + e]; a_ *= av[4 * g + e]; }
                A[g] = a_; B[g] = b_; }
#pragma unroll
            for (int g = 0; g < 4; ++g) { pA[g] = __shfl_xor(A[g], 32); pB[g] = __shfl_xor(B[g], 32); }
            float hcur = jh ? hc1 : hc0;
#pragma unroll
            for (int g = 0; g < 4; ++g) {
                if (hi == 0) { hs[g] = hcur; hcur = A[g] * hcur + B[g]; hcur = pA[g] * hcur + pB[g]; }
                else { hcur = pA[g] * hcur + pB[g]; hs[g] = hcur; hcur = A[g] * hcur + B[g]; }
            }
            if (jh) hc1 = hcur; else hc0 = hcur;
            if (!PASS2) {
                float pp = 1.f;
#pragma unroll
                for (int g = 0; g < 4; ++g) pp *= A[g] * pA[g];
                if (jh) Pt1 *= pp; else Pt0 *= pp;
            } else {
                const unsigned ob = (t0 + 4 * hi) * NZ + 512 + cC + 32 * jh;
#pragma unroll
                for (int g = 0; g < 4; ++g) { float hv = hs[g];
#pragma unroll
                    for (int e = 0; e < 4; ++e) { const int r = 4 * g + e; hv = av[r] * hv + bv[r];
                        const unsigned ix = ob + (unsigned)((8 * g + e) * NZ);
                        const float ug = bf2f(zb[ix]); zb[ix] = f2bf(hv * gelu_tanh(ug)); } }
            }
        }
    }
    if (!PASS2 && hi == 0) {
        const unsigned ix = ((unsigned)b * 64 + ch) * 512 + cC;
        aggP[ix] = Pt0; aggH[ix] = hc0; aggP[ix + 32] = Pt1; aggH[ix + 32] = hc1;
    }
}

template <int DK, bool FOX, int VAR = 0>
DEVI void attn_unit(unsigned char* smem, const bf16_t* Q, int ldq, const bf16_t* __restrict__ Kg, int ldk, const bf16_t* __restrict__ Vt, const float* __restrict__ kbias,
                    bf16_t* O, int ldo, int ocol0, int b, int h, int qb) {
    constexpr int KP = DK + 8, NS = DK / 16, KPR = DK / 8;
    bf16_t* Ks = (bf16_t*)smem;
    bf16_t* Vs = Ks + 2 * 64 * KP;
    float* kbs = (float*)(Vs + 3 * 64 * 72);
    const int tid = otid(), lane = tid & 63, r32 = lane & 31, hi = lane >> 5, w = tid >> 6;
    const size_t rowbase = (size_t)b * S_;
    const int q0 = qb * 256, NT = 4 * qb + 4, tmaxw = 4 * qb + (w >> 1);
    bf16x8 qr[NS];
    { const bf16_t* qp = Q + (rowbase + q0 + 32 * w + r32) * ldq + h * DK + 8 * hi;
#pragma unroll
      for (int s = 0; s < NS; ++s) qr[s] = *(const bf16x8*)(qp + 16 * s); }
    const int kr0 = tid / KPR, kc0 = tid % KPR;
    constexpr bool has1 = (DK == 96);
    const int kr1 = ((tid & 255) + 512) / KPR, kc1 = ((tid & 255) + 512) % KPR;
    const bf16_t* kg0 = Kg + (rowbase + kr0) * ldk + h * DK + 8 * kc0;
    const bf16_t* kg1 = Kg + (rowbase + kr1) * ldk + h * DK + 8 * kc1;
    const int vd = tid >> 3, vc = tid & 7;
    const bf16_t* vg = Vt + ((size_t)(b * 512 + h * 64 + vd)) * S_ + 8 * vc;
    const float* kbg = FOX ? (kbias + ((size_t)(b * 8 + h)) * S_ + lane) : nullptr;
    u32x4 rk0A = {}, rk1A = {}, rvA = {}, rk0B = {}, rk1B = {}, rvB = {}; float rkbA = 0.f, rkbB = 0.f;
#define ATT_LOAD(S_, t) do { rk0##S_ = *(const u32x4*)(kg0 + (size_t)(t) * 64 * ldk); if (has1) rk1##S_ = *(const u32x4*)(kg1 + (size_t)(t) * 64 * ldk); rv##S_ = *(const u32x4*)(vg + (t) * 64); \
        if (FOX) rkb##S_ = kbg[(t) * 64]; } while (0)
#define ATT_STORE(S_, kb_, vb_) do { *(u32x4*)(Ks + (kb_) * 64 * KP + kr0 * KP + 8 * kc0) = rk0##S_; if (has1) *(u32x4*)(Ks + (kb_) * 64 * KP + kr1 * KP + 8 * kc1) = rk1##S_; \
        *(u32x4*)(Vs + (vb_) * 64 * 72 + vd * 72 + 8 * vc) = rv##S_; if (FOX) kbs[(w * 3 + (vb_)) * 64 + lane] = rkb##S_; } while (0)
    ATT_LOAD(A, 0); ATT_STORE(A, 0, 0); ATT_LOAD(B, 1); __syncthreads();
    float m_run = -1e30f, l_run = 0.f; f32x16 o0 = {}, o1 = {}, p0 = {}, p1 = {};
    const int pr = (r32 & 19) | ((r32 & 4) << 1) | ((r32 & 8) >> 1);
    const int qloc = ((w & 1) << 5) + r32;
    const bool grpB = (w >= 4);
#define ATT_QK(kb_) do { const bf16_t* ks = Ks + (kb_) * 64 * KP + pr * KP + 8 * hi; p0 = f32x16{}; p1 = f32x16{}; \
        bf16x8 kf[2 * NS]; \
        _Pragma("unroll") for (int s = 0; s < NS; ++s) { kf[2 * s] = *(const bf16x8*)(ks + 16 * s); kf[2 * s + 1] = *(const bf16x8*)(ks + 32 * KP + 16 * s); } \
        __builtin_amdgcn_sched_barrier(0); \
        _Pragma("unroll") for (int s = 0; s < NS; ++s) { if (VAR == 2) { p0[s] += __builtin_bit_cast(f32x4, kf[2 * s])[0]; p1[s] += __builtin_bit_cast(f32x4, kf[2 * s + 1])[1]; } else { p0 = mfma32(kf[2 * s], qr[s], p0); p1 = mfma32(kf[2 * s + 1], qr[s], p1); } } } while (0)
#define ATT_SMPV(tt, vb_) do { \
        bf16x8 vf[8]; \
        { const bf16_t* vs = Vs + (vb_) * 64 * 72 + r32 * 72 + 8 * hi; \
          _Pragma("unroll") for (int blk = 0; blk < 4; ++blk) { vf[2 * blk] = *(const bf16x8*)(vs + 16 * blk); vf[2 * blk + 1] = *(const bf16x8*)(vs + 32 * 72 + 16 * blk); } } \
        if (FOX) { const float* kb = kbs + (w * 3 + (vb_)) * 64 + 8 * hi; \
            _Pragma("unroll") for (int g8 = 0; g8 < 2; ++g8) { \
                const f32x4 a0 = *(const f32x4*)(kb + 16 * g8), a1 = *(const f32x4*)(kb + 16 * g8 + 4), c0 = *(const f32x4*)(kb + 32 + 16 * g8), c1 = *(const f32x4*)(kb + 32 + 16 * g8 + 4); \
                _Pragma("unroll") for (int e = 0; e < 4; ++e) { p0[8 * g8 + e] += a0[e]; p0[8 * g8 + 4 + e] += a1[e]; p1[8 * g8 + e] += c0[e]; p1[8 * g8 + 4 + e] += c1[e]; } } \
            if ((tt) == tmaxw) { _Pragma("unroll") for (int r = 0; r < 16; ++r) { const int kv = (r & 7) + 8 * hi + 16 * (r >> 3); if (kv > qloc) p0[r] = -INFINITY; if (kv + 32 > qloc) p1[r] = -INFINITY; } } } \
        if (VAR != 1) { float mx = fmaxf(p0[0], p1[0]); \
        _Pragma("unroll") for (int r = 1; r < 16; ++r) mx = fmaxf(mx, fmaxf(p0[r], p1[r])); \
        mx = fmaxf(mx, __shfl_xor(mx, 32)); \
        const float mnew = fmaxf(m_run, mx); const float alpha = __builtin_amdgcn_exp2f(m_run - mnew); m_run = mnew; \
        float rs = 0.f; \
        _Pragma("unroll") for (int r = 0; r < 16; ++r) { p0[r] = __builtin_amdgcn_exp2f(p0[r] - mnew); p1[r] = __builtin_amdgcn_exp2f(p1[r] - mnew); rs += p0[r] + p1[r]; } \
        l_run = l_run * alpha + rs; \
        o0 = o0 * alpha; o1 = o1 * alpha; } \
        bf16x8 pf[4]; \
        _Pragma("unroll") for (int blk = 0; blk < 4; ++blk) { u32x4 pw; const int r0 = 8 * (blk & 1); \
            if (blk < 2) { pw.x = cvtpk(p0[r0], p0[r0 + 1]); pw.y = cvtpk(p0[r0 + 2], p0[r0 + 3]); pw.z = cvtpk(p0[r0 + 4], p0[r0 + 5]); pw.w = cvtpk(p0[r0 + 6], p0[r0 + 7]); } \
            else { pw.x = cvtpk(p1[r0], p1[r0 + 1]); pw.y = cvtpk(p1[r0 + 2], p1[r0 + 3]); pw.z = cvtpk(p1[r0 + 4], p1[r0 + 5]); pw.w = cvtpk(p1[r0 + 6], p1[r0 + 7]); } \
            pf[blk] = __builtin_bit_cast(bf16x8, pw); } \
        __builtin_amdgcn_sched_barrier(0); \
        _Pragma("unroll") for (int blk = 0; blk < 4; ++blk) { if (VAR == 2) { o0[blk] += __builtin_bit_cast(f32x4, vf[2 * blk])[0] * __builtin_bit_cast(f32x4, pf[blk])[0]; o1[blk] += __builtin_bit_cast(f32x4, vf[2 * blk + 1])[1]; } else { o0 = mfma32(vf[2 * blk], pf[blk], o0); o1 = mfma32(vf[2 * blk + 1], pf[blk], o1); } } } while (0)
    int vcur = 0, vprev = 2, vnext = 1;
#define ATT_ITER(t, SL_, SS_) do { \
        { const int tl_ = (VAR == 3) ? 0 : (((t) + 2 < NT) ? (t) + 2 : NT - 1); ATT_LOAD(SL_, tl_); } \
        if (!grpB) { if ((t) < NT && (t) <= tmaxw) { ATT_QK((t) & 1); ATT_SMPV((t), vcur); } } \
        else { if ((t) >= 1 && (t) - 1 <= tmaxw) { ATT_SMPV((t) - 1, vprev); } if ((t) < NT && (t) <= tmaxw) { ATT_QK((t) & 1); } } \
        ATT_STORE(SS_, ((t) + 1) & 1, vnext); \
        __syncthreads(); \
        vprev = vcur; vcur = vnext; vnext = (vnext == 2) ? 0 : vnext + 1; } while (0)
    for (int t = 0; t <= NT; t += 2) {
        ATT_ITER(t, A, B);
        if (t + 1 <= NT) ATT_ITER(t + 1, B, A);
    }
#undef ATT_ITER
#undef ATT_LOAD
#undef ATT_STORE
#undef ATT_QK
#undef ATT_SMPV
    const float lt = l_run + __shfl_xor(l_run, 32); const float inv = 1.f / lt;
    bf16_t* op = O + (rowbase + q0 + 32 * w + r32) * ldo + ocol0 + h * 64 + 4 * hi;
#pragma unroll
    for (int g = 0; g < 4; ++g) {
        u32x2 w2; w2.x = cvtpk(o0[4 * g] * inv, o0[4 * g + 1] * inv); w2.y = cvtpk(o0[4 * g + 2] * inv, o0[4 * g + 3] * inv); *(u32x2*)(op + 8 * g) = w2;
        w2.x = cvtpk(o1[4 * g] * inv, o1[4 * g + 1] * inv); w2.y = cvtpk(o1[4 * g + 2] * inv, o1[4 * g + 3] * inv); *(u32x2*)(op + 32 + 8 * g) = w2;
    }
}

#define SGB(m_, n_) __builtin_amdgcn_sched_group_barrier((m_), (n_), 0)
DEVI float max3f(float a, float b, float c) { return __builtin_fmaxf(__builtin_fmaxf(a, b), c); }
template <int DK, bool FOX, int VAR = 0>
DEVI void attn_unit2(unsigned char* smem, const bf16_t* Q, int ldq, const bf16_t* __restrict__ Kg, int ldk, const bf16_t* __restrict__ Vt, const float* __restrict__ kbias,
                     bf16_t* O, int ldo, int ocol0, int b, int h, int qb) {
    constexpr int KP = DK + 8, NS = DK / 16, KPR = DK / 8;
    bf16_t* Ks = (bf16_t*)smem;
    bf16_t* Vs = Ks + 2 * 64 * KP;
    float* kbs = (float*)(Vs + 3 * 64 * 72);
    const int tid = otid(), lane = tid & 63, r32 = lane & 31, hi = lane >> 5, w = tid >> 6;
    const size_t rowbase = (size_t)b * S_;
    const int q0 = qb * 256, NT = 4 * qb + 4, tmaxw = 4 * qb + (w >> 1);
    bf16x8 qr[NS];
    { const bf16_t* qp = Q + (rowbase + q0 + 32 * w + r32) * ldq + h * DK + 8 * hi;
#pragma unroll
      for (int s = 0; s < NS; ++s) qr[s] = *(const bf16x8*)(qp + 16 * s); }
    const int kr0 = tid / KPR, kc0 = tid % KPR;
    constexpr bool has1 = (DK == 96);
    const int kr1 = ((tid & 255) + 512) / KPR, kc1 = ((tid & 255) + 512) % KPR;
    const bf16_t* kgb = Kg + rowbase * ldk + h * DK;
    const unsigned ko0 = (unsigned)(kr0 * ldk + 8 * kc0), ko1 = (unsigned)(kr1 * ldk + 8 * kc1), kstep = (unsigned)(64 * ldk);
    const int vd = tid >> 3, vc = tid & 7;
    const bf16_t* vgb = Vt + ((size_t)(b * 512 + h * 64)) * S_;
    const unsigned vo = (unsigned)(vd * S_ + 8 * vc);
    const float* kbgb = FOX ? (kbias + ((size_t)(b * 8 + h)) * S_) : nullptr;
    u32x4 rk0A = {}, rk1A = {}, rvA = {}, rk0B = {}, rk1B = {}, rvB = {}; float rkbA = 0.f, rkbB = 0.f;
#define ATT_LOAD(S_, t) do { rk0##S_ = *(const u32x4*)(kgb + (ko0 + (unsigned)(t) * kstep)); if (has1) rk1##S_ = *(const u32x4*)(kgb + (ko1 + (unsigned)(t) * kstep)); rv##S_ = *(const u32x4*)(vgb + (vo + (unsigned)(t) * 64u)); \
        if (FOX) rkb##S_ = kbgb[(unsigned)(t) * 64u + (unsigned)lane]; } while (0)
#define ATT_STORE(S_, kb_, vb_) do { *(u32x4*)(Ks + (kb_) * 64 * KP + kr0 * KP + 8 * kc0) = rk0##S_; if (has1) *(u32x4*)(Ks + (kb_) * 64 * KP + kr1 * KP + 8 * kc1) = rk1##S_; \
        *(u32x4*)(Vs + (vb_) * 64 * 72 + vd * 72 + 8 * vc) = rv##S_; if (FOX) kbs[(w * 3 + (vb_)) * 64 + lane] = rkb##S_; } while (0)
    const int pr = (r32 & 19) | ((r32 & 4) << 1) | ((r32 & 8) >> 1);
    const int qloc = ((w & 1) << 5) + r32;
    float m_run = 0.f, l_run = 0.f, al = 1.f; bool resc = false;
    f32x16 o0 = {}, o1 = {}, pa0 = {}, pa1 = {}, pb0 = {}, pb1 = {}, negm = {};
#define ATT_QKREL(PN, kbuf_, sl_) do { \
        const bf16_t* ks = Ks + (kbuf_) * 64 * KP + pr * KP + 8 * hi; \
        if (FOX) { const float* kb = kbs + (w * 3 + (sl_)) * 64 + 8 * hi; \
            _Pragma("unroll") for (int g8 = 0; g8 < 2; ++g8) { \
                const f32x4 a0 = *(const f32x4*)(kb + 16 * g8), a1 = *(const f32x4*)(kb + 16 * g8 + 4), c0 = *(const f32x4*)(kb + 32 + 16 * g8), c1 = *(const f32x4*)(kb + 32 + 16 * g8 + 4); \
                _Pragma("unroll") for (int e = 0; e < 4; ++e) { PN##0[8 * g8 + e] = a0[e] - m_run; PN##0[8 * g8 + 4 + e] = a1[e] - m_run; PN##1[8 * g8 + e] = c0[e] - m_run; PN##1[8 * g8 + 4 + e] = c1[e] - m_run; } } } \
        _Pragma("unroll") for (int s = 0; s < NS; ++s) { const bf16x8 k0 = *(const bf16x8*)(ks + 16 * s), k1 = *(const bf16x8*)(ks + 32 * KP + 16 * s); \
            if (!FOX && s == 0) { PN##0 = mfma32(k0, qr[0], negm); PN##1 = mfma32(k1, qr[0], negm); } else { PN##0 = mfma32(k0, qr[s], PN##0); PN##1 = mfma32(k1, qr[s], PN##1); } } } while (0)
#define ATT_MASK(PN) do { _Pragma("unroll") for (int r = 0; r < 16; ++r) { const int kv = (r & 7) + 8 * hi + 16 * (r >> 3); if (kv > qloc) PN##0[r] = -INFINITY; if (kv + 32 > qloc) PN##1[r] = -INFINITY; } } while (0)
#define ATT_ROWMAX(PN, mx_) do { \
        float mxa = max3f(PN##0[0], PN##0[1], PN##1[0]), mxb = max3f(PN##0[2], PN##0[3], PN##1[1]); mxa = max3f(mxa, PN##1[2], PN##1[3]); \
        _Pragma("unroll") for (int r = 4; r < 16; r += 4) { mxa = max3f(mxa, PN##0[r], PN##0[r + 1]); mxb = max3f(mxb, PN##0[r + 2], PN##0[r + 3]); mxa = max3f(mxa, PN##1[r], PN##1[r + 1]); mxb = max3f(mxb, PN##1[r + 2], PN##1[r + 3]); } \
        mx_ = fmaxf(mxa, mxb); \
        { auto rr = __builtin_amdgcn_permlane32_swap(__float_as_uint(mx_), __float_as_uint(mx_), false, false); mx_ = fmaxf(__uint_as_float(rr[0]), __uint_as_float(rr[1])); } } while (0)
#define ATT_MOVEREF(PN, dl_) do { m_run += (dl_); \
        _Pragma("unroll") for (int r = 0; r < 16; ++r) { PN##0[r] -= (dl_); PN##1[r] -= (dl_); } \
        if (!FOX) { _Pragma("unroll") for (int r = 0; r < 16; ++r) negm[r] = -m_run; } \
        al = __builtin_amdgcn_exp2f(-(dl_)); resc = true; } while (0)
    ATT_LOAD(A, 0); ATT_STORE(A, 0, 0); ATT_LOAD(B, 1); __syncthreads();
    ATT_STORE(B, 1, 1);
    { const int t2 = (2 < NT) ? 2 : NT - 1, t3 = (3 < NT) ? 3 : NT - 1; ATT_LOAD(A, t2); ATT_LOAD(B, t3); }
    {
        ATT_QKREL(pa, 0, 0);
        if (FOX && tmaxw == 0) ATT_MASK(pa);
        float mx0; ATT_ROWMAX(pa, mx0);
        ATT_MOVEREF(pa, mx0); resc = false; al = 1.f;
    }
    __syncthreads();
#define ATT_BODY(t, PC, PN, MASK_) do { \
        if (resc) { o0 = o0 * al; o1 = o1 * al; l_run *= al; } \
        const bf16_t* vs = Vs + vcur * 64 * 72 + r32 * 72 + 8 * hi; \
        ATT_QKREL(PN, ((t) + 1) & 1, vnext); \
        float rs = 0.f; \
        _Pragma("unroll") for (int r = 0; r < 16; ++r) { PC##0[r] = __builtin_amdgcn_exp2f(PC##0[r]); PC##1[r] = __builtin_amdgcn_exp2f(PC##1[r]); rs += PC##0[r] + PC##1[r]; } \
        l_run += rs; \
        bf16x8 pf[4]; \
        _Pragma("unroll") for (int blk = 0; blk < 4; ++blk) { u32x4 pw; const int r0 = 8 * (blk & 1); \
            if (blk < 2) { pw.x = cvtpk(PC##0[r0], PC##0[r0 + 1]); pw.y = cvtpk(PC##0[r0 + 2], PC##0[r0 + 3]); pw.z = cvtpk(PC##0[r0 + 4], PC##0[r0 + 5]); pw.w = cvtpk(PC##0[r0 + 6], PC##0[r0 + 7]); } \
            else { pw.x = cvtpk(PC##1[r0], PC##1[r0 + 1]); pw.y = cvtpk(PC##1[r0 + 2], PC##1[r0 + 3]); pw.z = cvtpk(PC##1[r0 + 4], PC##1[r0 + 5]); pw.w = cvtpk(PC##1[r0 + 6], PC##1[r0 + 7]); } \
            pf[blk] = __builtin_bit_cast(bf16x8, pw); } \
        _Pragma("unroll") for (int blk = 0; blk < 4; ++blk) { const bf16x8 v0 = *(const bf16x8*)(vs + 16 * blk), v1 = *(const bf16x8*)(vs + 32 * 72 + 16 * blk); o0 = mfma32(v0, pf[blk], o0); o1 = mfma32(v1, pf[blk], o1); } \
        if (MASK_) ATT_MASK(PN); \
        float mxn; ATT_ROWMAX(PN, mxn); \
          \
        SGB(0x100, FOX ? 10 : 6); if (FOX) SGB(0x002, 32); \
        _Pragma("unroll") for (int i_ = 0; i_ < 2 * NS; ++i_) { SGB(0x008, 1); SGB(0x100, 1); SGB(0x002, (DK == 96) ? 9 : 13); } \
        SGB(0x100, 4); \
        _Pragma("unroll") for (int i_ = 0; i_ < 8; ++i_) { SGB(0x008, 1); SGB(0x100, 1); SGB(0x002, 3); } \
        resc = false; \
        if (__any(mxn > 8.f)) { const float dl = fmaxf(mxn, 0.f); ATT_MOVEREF(PN, dl); } \
    } while (0)
    int vcur = 0, vnext = 1, vnn = 2;
#define ATT_ITER(t, PC, PN, SL_, SS_) do { \
          \
        if (VAR != 5) { ATT_STORE(SS_, (t) & 1, vnn); } \
        { const int tl_ = (VAR == 3) ? 0 : (((t) + 4 < NT) ? (t) + 4 : NT - 1); if (VAR != 5) ATT_LOAD(SS_, tl_); } \
        if ((t) <= tmaxw) { if (FOX && (t) + 1 == tmaxw) ATT_BODY(t, PC, PN, true); else ATT_BODY(t, PC, PN, false); } \
        if (VAR != 5 && VAR != 6) __syncthreads(); \
        { const int v_ = vcur; vcur = vnext; vnext = vnn; vnn = v_; } } while (0)
    for (int t = 0; t < NT; t += 2) {
        ATT_ITER(t, pa, pb, B, A);
        ATT_ITER(t + 1, pb, pa, A, B);
    }
#undef ATT_ITER
#undef ATT_BODY
#undef ATT_QKREL
#undef ATT_MASK
#undef ATT_ROWMAX
#undef ATT_MOVEREF
#undef ATT_LOAD
#undef ATT_STORE
    const float lt = l_run + __shfl_xor(l_run, 32); const float inv = 1.f / lt;
    bf16_t* op = O + (rowbase + q0 + 32 * w + r32) * ldo + ocol0 + h * 64 + 4 * hi;
#pragma unroll
    for (int g = 0; g < 4; ++g) {
        u32x2 w2; w2.x = cvtpk(o0[4 * g] * inv, o0[4 * g + 1] * inv); w2.y = cvtpk(o0[4 * g + 2] * inv, o0[4 * g + 3] * inv); *(u32x2*)(op + 8 * g) = w2;
        w2.x = cvtpk(o1[4 * g] * inv, o1[4 * g + 1] * inv); w2.y = cvtpk(o1[4 * g + 2] * inv, o1[4 * g + 3] * inv); *(u32x2*)(op + 32 + 8 * g) = w2;
    }
}

constexpr int NPHASE = 20;
template <int ph> DEVI void phase_body(const Params& P, unsigned char* lds, const int G, const int vcu, const bool dup = false) {
    const int gsz = G * 512;
    const int tid = otid(), gtid = blockIdx.x * 512 + tid;
    unsigned char* ws = P.ws;
#define PIN(i) (P.in[i])
    bf16_t* const WB = (bf16_t*)(ws + WS_W);
    bf16_t* const XB = (bf16_t*)(ws + WS_XB); bf16_t* const ZB = (bf16_t*)(ws + WS_ZB); bf16_t* const FVT = (bf16_t*)(ws + WS_FVT);
    bf16_t* const QM = (bf16_t*)(ws + WS_QM); bf16_t* const KM = (bf16_t*)(ws + WS_KM); bf16_t* const VTM = (bf16_t*)(ws + WS_VTM);
    bf16_t* const GS = (bf16_t*)(ws + WS_GS); bf16_t* const MG = (bf16_t*)(ws + WS_MG); bf16_t* const PB = (bf16_t*)(ws + WS_PB);
    float* const SSQA = (float*)(ws + SM_SSQA); float* const SSQB = (float*)(ws + SM_SSQB); float* const SSQC = (float*)(ws + SM_SSQC);
    float* const SSQQ = (float*)(ws + SM_SSQQ); float* const SSQKV = (float*)(ws + SM_SSQKV);
    float* const FLOG = (float*)(ws + SM_FLOG); float* const KBIAS = (float*)(ws + SM_KBIAS); float* const AGGP = (float*)(ws + SM_AGGP); float* const AGGH = (float*)(ws + SM_AGGH);
    float* const TCOS = (float*)(ws + SM_TCOS); float* const TSIN = (float*)(ws + SM_TSIN);
    float* const OUT = P.out;
    const float* const XIN = PIN(0);
    if (ph == 0) {
        prep_all(lds, P, WB, G);
        rope_table(TCOS, TSIN, gtid, gsz);
        for (int i = gtid; i < T_; i += gsz) { SSQQ[i] = 0.f; SSQKV[i] = 0.f; }
        rownorm_phase(XIN, XB, SSQA, G);
    } else if (ph == NPHASE - 1) {
        finalnorm_phase(OUT, PIN(27), SSQA, G);
    } else {
        constexpr int L = (ph - 1) / 9, sp = (ph - 1) % 9;
        const bf16_t* W = WB + (size_t)L * W_LAYER;
        constexpr int ng = (sp == 0) ? 2 : (sp == 1) ? 3 : (sp == 3) ? 6 : (sp == 2) ? 0 : 1;
        if (sp == 0) {
            for (int i = gtid; i < T_; i += gsz) { SSQB[i] = 0.f; SSQC[i] = 0.f; }
            const float* pl = PIN(1) + (size_t)L * T_ * 256;
            for (int i = gtid; i < T_ * 256 / 8; i += gsz) {
                const f32x4 a = ((const f32x4*)pl)[2 * i], c = ((const f32x4*)pl)[2 * i + 1];
                u32x4 w4; w4.x = cvtpk(a[0], a[1]); w4.y = cvtpk(a[2], a[3]); w4.z = cvtpk(c[0], c[1]); w4.w = cvtpk(c[2], c[3]); ((u32x4*)PB)[i] = w4;
            }
        } else if (sp == 1) {
            krope_fill(ZB, KM, TCOS, TSIN, gtid, gsz);
            fox_cumsum(lds, FLOG, KBIAS, G);
            for (int u = blockIdx.x; u < 256; u += G) {
#ifndef NO_LRU
                lru_unit<false>(lds, ZB, W + W_LA, W + W_LX, PIN(5) + L * 2048, PIN(6) + L * 512, PIN(8) + L * 512, PIN(10) + L * 512, PIN(11) + L * 512, AGGP, AGGH, u >> 6, u & 63);
#endif
            }
            __syncthreads();
        } else if (sp == 2) {
#ifdef PROBE_ATTN_VAR
            if (L == 0) for (int deal = vcu; deal < 512; deal += G) {
                const int ty = deal >> 8, idx = deal & 255, bh = idx >> 3, s = idx & 7, b = bh >> 3, h = bh & 7;
                for (int i = 0; i < 4; ++i) {
                    const int qb = (i == 0) ? s : (i == 1) ? 15 - s : (i == 2) ? 16 + s : 31 - s;
                    if (ty == 0) attn_unit2<64, true, PROBE_ATTN_VAR>(lds, ZB + 1792, NZ, ZB + 2304, NZ, FVT, KBIAS, (bf16_t*)OUT, 2048, 0, b, h, qb);
                    else attn_unit2<96, false, PROBE_ATTN_VAR>(lds, QM, 768, KM, 768, VTM, nullptr, (bf16_t*)OUT, 2048, 512, b, h, qb);
                }
            }
#endif
            for (int deal = vcu; deal < 512; deal += G) {
                const int ty = deal >> 8, idx = deal & 255, bh = idx >> 3, s = idx & 7, b = bh >> 3, h = bh & 7;
                for (int i = 0; i < 4; ++i) {
                    const int qb = (i == 0) ? s : (i == 1) ? 15 - s : (i == 2) ? 16 + s : 31 - s;
#ifndef NO_ATTN
                    if (ty == 0) attn_unit2<64, true>(lds, ZB + 1792, NZ, ZB + 2304, NZ, FVT, KBIAS, ZB, NZ, 1792, b, h, qb);
                    else attn_unit2<96, false>(lds, QM, 768, KM, 768, VTM, nullptr, ZB, NZ, 1024, b, h, qb);
#endif
                }
            }
            for (int u = blockIdx.x; u < 256; u += G) {
#ifndef NO_LRU
                lru_unit<true>(lds, ZB, W + W_LA, W + W_LX, PIN(5) + L * 2048, PIN(6) + L * 512, PIN(8) + L * 512, PIN(10) + L * 512, PIN(11) + L * 512, AGGP, AGGH, u >> 6, u & 63);
#endif
            }
        } else if (sp == 5) {
            for (int i = gtid; i < T_; i += gsz) { SSQA[i] = 0.f; SSQQ[i] = 0.f; SSQKV[i] = 0.f; }
        }
#pragma nounroll
        for (int gi = 0; gi < ng; ++gi) {
#ifdef PROBE_GI_PARITY
            if (dup && (gi & 1) != PROBE_GI_PARITY) continue;
#endif
            pg8::Gemm g{}; EpiGen E{};
            if (sp == 0) {
                if (gi == 0) { g = pg8::Gemm{XB, W + W_IN, T_, 2816, 1024, 1024, 1024, 1}; E.mode = MZ; E.f0 = SSQA; E.f1 = PIN(16) + L * 8; E.b0 = ZB; E.o0 = FLOG; E.o1 = SSQQ; E.o2 = SSQKV; }
                else { g = pg8::Gemm{W + W_V, XB, 512, T_, 1024, 1024, 1024, 1}; E.mode = MVT; E.i0 = 0; E.f0 = SSQA; E.b0 = FVT; }
            } else if (sp == 1) {
                if (gi == 0) { g = pg8::Gemm{ZB + 1024, W + W_UQ, T_, 768, 384, NZ, 384, 0}; E.mode = MQ; E.f0 = SSQQ; E.f1 = TCOS; E.f2 = TSIN; E.b0 = QM; }
                else if (gi == 1) { g = pg8::Gemm{ZB + 1408, W + W_UK, T_, 512, 256, NZ, 256, 1}; E.mode = MK; E.f0 = SSQKV; E.b0 = KM; }
                else { g = pg8::Gemm{W + W_UV, ZB + 1408, 512, T_, 256, 256, NZ, 1}; E.mode = MVT; E.i0 = 1; E.f0 = SSQKV; E.b0 = VTM; }
            } else if (sp == 3) {
                const int br = gi >> 1;
                if ((gi & 1) == 0) { g = pg8::Gemm{XB, W + W_G + (size_t)br * 1024 * 1024, T_, 1024, 1024, 1024, 1024, 1}; E.mode = MGATE; E.f0 = SSQA; E.f1 = PIN(4) + L * 3072 + br * 1024; E.b0 = GS; }
                else { const bf16_t* A = (br == 0) ? ZB + 512 : (br == 1) ? ZB + 1024 : ZB + 1792; const bf16_t* Bw = W + ((br == 0) ? W_BA : (br == 1) ? W_BB : W_BC);
                       g = pg8::Gemm{A, Bw, T_, 1024, 512, NZ, 512, 1}; E.mode = MY; E.i0 = (br == 0); E.b1 = GS; E.b0 = MG; }
            } else if (sp == 4) { g = pg8::Gemm{MG, W + W_O, T_, 1024, 1024, 1024, 1024, 1}; E.mode = MRES; E.f0 = (L == 0) ? XIN : OUT; E.o0 = OUT; E.b0 = XB; E.o1 = SSQB; }
            else if (sp == 5) { g = pg8::Gemm{XB, W + W_GU, T_, 5632, 1024, 1024, 1024, 1}; E.mode = MFFN; E.f0 = SSQB; E.b0 = ZB; }
            else if (sp == 6) { g = pg8::Gemm{ZB, W + W_DN, T_, 1024, 2816, 2816, 2816, 1}; E.mode = MRES; E.f0 = OUT; E.o0 = OUT; E.b0 = XB; E.o1 = SSQC; }
            else if (sp == 7) { g = pg8::Gemm{XB, W + W_PG, T_, 1024, 1024, 1024, 1024, 1}; E.mode = MPG; E.f0 = SSQC; E.b0 = GS; }
            else { g = pg8::Gemm{PB, W + W_PL, T_, 1024, 256, 256, 256, 1}; E.mode = MPLE; E.b1 = GS; E.f0 = OUT; E.o0 = OUT; E.b0 = (L == 1) ? nullptr : XB; E.o1 = SSQA; }
            pg8::StaticOrder S; S.init(g.M, g.N, G, (int)blockIdx.x);
#ifndef NO_GEMM
            pg8::gemm_phase<EpiGen, pg8::StaticOrder, true, true>((PG8_LAS unsigned char*)lds, g, S, E);
#endif
            __syncthreads();
        }
    }
}
template <int ph> DEVI void run_phases(const Params& P, unsigned char* lds, const int G, const int vcu, const XcdBarrier& bar) {
    if constexpr (ph < NPHASE) {
        if (ph >= P.ph_lo && ph < P.ph_hi) {
            phase_body<ph>(P, lds, G, vcu);
#ifdef PROBE_DUP_PH
            if (ph == PROBE_DUP_PH) { xcd_barrier(bar); phase_body<ph>(P, lds, G, vcu, true); }
#endif
            if (ph + 1 < P.ph_hi) xcd_barrier(bar);
        }
        run_phases<ph + 1>(P, lds, G, vcu, bar);
    }
}
__global__ void __launch_bounds__(512, 2) mk_fwd(Params P) {
    extern __shared__ __attribute__((aligned(16))) unsigned char lds[];
    const int G = gridDim.x;
    const int vcu = (G % 8 == 0) ? ((int)(blockIdx.x % 8) * (G / 8) + (int)(blockIdx.x / 8)) : (int)blockIdx.x;
    volatile LAS unsigned* st = (volatile LAS unsigned*)((LAS unsigned char*)lds + LDS_GEMM);
    if (threadIdx.x < 4) st[threadIdx.x] = 0u;
    __syncthreads();
    XcdBarrier bar; bar.bar = (unsigned*)(P.ws + SM_BAR); bar.x = 0; bar.st = st;
    if (P.ph_hi - P.ph_lo > 1) bar = xcd_barrier_post((unsigned*)(P.ws + SM_BAR), st);
    if (P.ph_lo > P.ph_hi) cg::this_grid().sync();
    run_phases<0>(P, lds, G, vcu, bar);
}

extern "C" void kernel_launch(void* const* d_in, const int* in_sizes, int n_in, void* d_out, int out_size, void* d_ws, size_t ws_size, hipStream_t stream) {
    static int grid = 0;
    if (grid == 0) {
        if (n_in != 28 || ws_size < WS_END) { fprintf(stderr, "kernel_launch: unexpected n_in %d / ws_size %zu (need %zu)\n", n_in, ws_size, (size_t)WS_END); grid = -1; return; }
        int dev = 0, cus = 0, per_cu = 0;
        (void)hipGetDevice(&dev); (void)hipDeviceGetAttribute(&cus, hipDeviceAttributeMultiprocessorCount, dev);
        if (hipFuncSetAttribute((const void*)mk_fwd, hipFuncAttributeMaxDynamicSharedMemorySize, LDS_BYTES) != hipSuccess) { fprintf(stderr, "kernel_launch: hipFuncSetAttribute failed\n"); grid = -1; return; }
        if (hipOccupancyMaxActiveBlocksPerMultiprocessor(&per_cu, (const void*)mk_fwd, 512, LDS_BYTES) != hipSuccess || per_cu < 1) { fprintf(stderr, "kernel_launch: occupancy query says %d\n", per_cu); per_cu = 1; }
        (void)hipGetLastError();
        grid = cus;
        if (grid <= 0) grid = 256;
    }
    if (grid < 0) return;
    (void)hipMemsetAsync((unsigned char*)d_ws + SM_BAR, 0, XCD_BAR_WORDS * 4, stream);
    Params p{};
    for (int i = 0; i < 28; ++i) p.in[i] = (const float*)d_in[i];
    p.out = (float*)d_out; p.ws = (unsigned char*)d_ws;
#if MK_MULTI
    for (int ph = 0; ph < NPHASE; ++ph) { p.ph_lo = ph; p.ph_hi = ph + 1; hipLaunchKernelGGL(mk_fwd, dim3(grid), dim3(512), LDS_BYTES, stream, p); }
#else
    p.ph_lo = 0; p.ph_hi = NPHASE;
    void* args[] = {&p};
    hipError_t e = hipLaunchCooperativeKernel((const void*)mk_fwd, dim3(grid), dim3(512), args, LDS_BYTES, stream);
    if (e != hipSuccess) fprintf(stderr, "kernel_launch: cooperative launch failed: %s (grid %d)\n", hipGetErrorString(e), grid);
#endif
}
```

```cpp
#include <hip/hip_runtime.h>
#include <hip/hip_cooperative_groups.h>
#include <cstdio>
#include <cstdint>
namespace cg = cooperative_groups;

#ifndef MK_MULTI
#define MK_MULTI 0
#endif

#define DEVI __device__ __forceinline__
typedef unsigned short bf16_t;
typedef short bf16x8 __attribute__((ext_vector_type(8)));
typedef float f32x4 __attribute__((ext_vector_type(4)));
typedef float f32x16 __attribute__((ext_vector_type(16)));
typedef unsigned u32x2 __attribute__((ext_vector_type(2)));
typedef unsigned u32x4 __attribute__((ext_vector_type(4)));
typedef float f32x2_t __attribute__((ext_vector_type(2)));
typedef __bf16 bf16x2_t __attribute__((ext_vector_type(2)));

constexpr int T_ = 32768, S_ = 8192, NZ = 2816;
constexpr float EPS = 1e-6f, LOG2E = 1.4426950408889634f;
constexpr float QSCALE_MLA = 0.10206207261596575f * 1.4426950408889634f;
constexpr float QSCALE_FOX = 0.125f * 1.4426950408889634f;

DEVI unsigned cvtpk(float lo, float hi) { f32x2_t v = {lo, hi}; bf16x2_t b = __builtin_convertvector(v, bf16x2_t); return __builtin_bit_cast(unsigned, b); }
DEVI bf16_t f2bf(float x) { return (bf16_t)(cvtpk(x, 0.f) & 0xffffu); }
DEVI float bf2f(bf16_t v) { return __uint_as_float(((unsigned)v) << 16); }
DEVI float bflo(unsigned w) { return __uint_as_float(w << 16); }
DEVI float bfhi(unsigned w) { return __uint_as_float(w & 0xffff0000u); }
DEVI float sigm(float x) { return __builtin_amdgcn_rcpf(1.f + __builtin_amdgcn_exp2f(-1.4426950408889634f * x)); }
DEVI float logsig(float x) { return fminf(x, 0.f) - log1pf(expf(-fabsf(x))); }
DEVI int otid() { int t = threadIdx.x; asm volatile("" : "+v"(t)); return t; }
DEVI int crow(int r, int hi) { return (r & 3) + 8 * (r >> 2) + 4 * hi; }

namespace pg8 {
#define PG8_LAS __attribute__((address_space(3)))
constexpr int BM = 256, BK = 64, HALF = 128, HTB = HALF * BK * 2, STAGE_BYTES = 8 * HTB, NXCD = 8, WGM = 8;
__host__ __device__ __forceinline__ int lds_byte(int r, int c) { const int st = (r >> 4) * 2 + (c >> 5), rr = r & 15, cc = c & 31, ob = rr * 64 + cc * 2; return st * 1024 + (ob ^ (((ob >> 9) & 1) << 5)); }
__host__ __device__ __forceinline__ void stage_rc(int b, int& R, int& C) { const int st = b / 1024, sb = b % 1024, swz = sb ^ (((sb >> 9) & 1) << 5); R = (st >> 1) * 16 + swz / 64; C = (st & 1) * 32 + (swz % 64) / 2; }
struct Unit { int pm, pn; };
struct Gemm { const bf16_t* A; const bf16_t* Bt; int M, N, K, lda, ldb, perm; };
__host__ __device__ __forceinline__ int perm32(int rho) { const int n = rho >> 4, i = rho & 15; return 8 * (i >> 2) + 4 * n + (i & 3); }
struct StaticOrder {
    int nM, nN, nwg, G, c;
    __device__ void init(int M, int N, int G_, int c_) { nM = M / BM; nN = N / BM; nwg = nM * nN; G = G_; c = c_; }
    __device__ bool next(int i, Unit& u) const {
        const long L = (long)i * G + c; if (L >= nwg) return false;
        int wgid = (int)L; { const int q = nwg / NXCD, r = nwg % NXCD, xcd = wgid % NXCD, off = wgid / NXCD; wgid = (xcd < r ? xcd * (q + 1) : r * (q + 1) + (xcd - r) * q) + off; }
        const int nig = WGM * nN, gid = wgid / nig, fm = gid * WGM, gsz = (nM - fm) < WGM ? (nM - fm) : WGM;
        u.pm = fm + ((wgid % nig) % gsz); u.pn = (wgid % nig) / gsz; return true;
    }
    __device__ __forceinline__ void a_ready(const Unit&) const {}
    __device__ __forceinline__ void done(const Unit&) const {}
};

template <class Epi, class Sched, bool ALIGN_EPI = false, bool SP2 = false>
__device__ __forceinline__ void gemm_phase(PG8_LAS unsigned char* lds, const Gemm g, const Sched& S, const Epi& E) {
    const int tid = otid(), wid = __builtin_amdgcn_readfirstlane(tid >> 6), lane = tid & 63, wr = wid >> 2, wc = wid & 3, fr = lane & 15, fq = lane >> 4;
    const int K = g.K, nt = K / BK;
    unsigned voffA[2], voffB[2];
#pragma unroll
    for (int i = 0; i < 2; ++i) { int R, C; stage_rc(tid * 16 + i * 8192, R, C);
        const int Rb = g.perm ? ((R & ~31) + perm32(R & 31)) : R;
        voffA[i] = (unsigned)(R * g.lda + C) * 2u; voffB[i] = (unsigned)(Rb * g.ldb + C) * 2u; }
    const size_t kstep = (size_t)(BK * 2);
    const size_t hstepA = (size_t)HALF * g.lda * 2, hstepB = (size_t)HALF * g.ldb * 2;
    const size_t tstepA = 2 * hstepA, tstepB = 2 * hstepB;
    const unsigned ldsw = (unsigned)wid * 1024u;
    const int aoff = lds_byte(wr * 64 + fr, fq * 8), boff = lds_byte(wc * 32 + fr, fq * 8);
#define PG8_SA(b, h) (((b) * 2 + (h)) * HTB)
#define PG8_SB(b, h) ((4 + (b) * 2 + (h)) * HTB)
#define PG8_STAGE(bufoff, gbase, voff) do { _Pragma("unroll") for (int _i = 0; _i < 2; ++_i) \
        __builtin_amdgcn_global_load_lds((const unsigned*)((const char*)(gbase) + (voff)[_i]), (PG8_LAS unsigned*)(lds + (bufoff) + ldsw + _i * 8192), 16, 0, 0); } while (0)
#define PG8_LDA(dst, b, h) do { _Pragma("unroll") for (int m = 0; m < 4; ++m) _Pragma("unroll") for (int k = 0; k < 2; ++k) dst[m][k] = *(const PG8_LAS bf16x8*)(lds + PG8_SA(b, h) + aoff + m * 2048 + k * 1024); } while (0)
#define PG8_LDB(dst, b, h) do { _Pragma("unroll") for (int n = 0; n < 2; ++n) _Pragma("unroll") for (int k = 0; k < 2; ++k) dst[n][k] = *(const PG8_LAS bf16x8*)(lds + PG8_SB(b, h) + boff + n * 2048 + k * 1024); } while (0)
#define PG8_MMA(ai, bj, At, Bt) do { __builtin_amdgcn_s_setprio(1); _Pragma("unroll") for (int m = 0; m < 4; ++m) _Pragma("unroll") for (int n = 0; n < 2; ++n) _Pragma("unroll") for (int k = 0; k < 2; ++k) \
        acc[ai][bj][m][n] = __builtin_amdgcn_mfma_f32_16x16x32_bf16(Bt[n][k], At[m][k], acc[ai][bj][m][n], 0, 0, 0); __builtin_amdgcn_s_setprio(0); } while (0)
#define PG8_WAIT_V(n) asm volatile("s_waitcnt vmcnt(" #n ")" ::: "memory")
#define PG8_WAIT_L(n) asm volatile("s_waitcnt lgkmcnt(" #n ")" ::: "memory")
#define PG8_BAR __builtin_amdgcn_s_barrier()
#define PG8_SCHED __builtin_amdgcn_sched_barrier(0)
    Unit cur, nxt; int ui = 0;
    if (!S.next(0, cur)) return;
    f32x4 acc[2][2][4][2];
#pragma unroll
    for (int a = 0; a < 2; ++a)
#pragma unroll
        for (int b = 0; b < 2; ++b)
#pragma unroll
            for (int m = 0; m < 4; ++m)
#pragma unroll
                for (int n = 0; n < 2; ++n) acc[a][b][m][n] = (f32x4){0.f, 0.f, 0.f, 0.f};
    bf16x8 At[4][2], B0[2][2], B1[2][2];
    const char* cA = (const char*)g.A + (size_t)cur.pm * tstepA; const char* cB = (const char*)g.Bt + (size_t)cur.pn * tstepB;
    S.a_ready(cur);
    if constexpr (SP2) {
        PG8_STAGE(PG8_SB(0, 0), cB, voffB); PG8_STAGE(PG8_SB(0, 1), cB + hstepB, voffB); PG8_STAGE(PG8_SA(0, 0), cA, voffA); PG8_STAGE(PG8_SA(0, 1), cA + hstepA, voffA);
        if (wr == 1) PG8_BAR;
        PG8_WAIT_V(2); PG8_BAR;
        PG8_STAGE(PG8_SB(1, 0), cB + kstep, voffB); PG8_STAGE(PG8_SA(1, 0), cA + kstep, voffA); PG8_STAGE(PG8_SB(1, 1), cB + hstepB + kstep, voffB);
        PG8_WAIT_V(6); PG8_BAR;
    } else {
        PG8_STAGE(PG8_SB(0, 0), cB, voffB); PG8_STAGE(PG8_SA(0, 0), cA, voffA); PG8_STAGE(PG8_SB(0, 1), cB + hstepB, voffB); PG8_STAGE(PG8_SA(0, 1), cA + hstepA, voffA);
        if (wr == 1) PG8_BAR;
        PG8_WAIT_V(4); PG8_BAR;
        PG8_STAGE(PG8_SB(1, 0), cB + kstep, voffB); PG8_STAGE(PG8_SA(1, 0), cA + kstep, voffA); PG8_STAGE(PG8_SB(1, 1), cB + hstepB + kstep, voffB);
        PG8_WAIT_V(6); PG8_BAR;
    }
    for (;;) {
        const bool has_next = S.next(ui + 1, nxt);
        const char* nA = has_next ? (const char*)g.A + (size_t)nxt.pm * tstepA : cA; const char* nB = has_next ? (const char*)g.Bt + (size_t)nxt.pn * tstepB : cB;
        for (int t = 0; t < nt; t += 2) {
            const bool last = (t == nt - 2);
            const char* a1 = cA + (size_t)(t + 1) * kstep;
            const char* a2 = last ? nA : cA + (size_t)(t + 2) * kstep; const char* b2 = last ? nB : cB + (size_t)(t + 2) * kstep;
            const char* a3 = a2 + kstep; const char* b3 = b2 + kstep;
            if (last && has_next) S.a_ready(nxt);
            if constexpr (SP2) {
            PG8_LDB(B0, 0, 0); PG8_LDB(B1, 0, 1); PG8_SCHED; PG8_LDA(At, 0, 0); PG8_STAGE(PG8_SA(1, 1), a1 + hstepA, voffA);
            PG8_WAIT_V(8); PG8_WAIT_L(0); PG8_BAR; PG8_MMA(0, 0, At, B0); PG8_MMA(0, 1, At, B1); PG8_BAR; PG8_SCHED;
            PG8_LDA(At, 0, 1); PG8_STAGE(PG8_SB(0, 0), b2, voffB); PG8_STAGE(PG8_SB(0, 1), b2 + hstepB, voffB); PG8_STAGE(PG8_SA(0, 0), a2, voffA);
            PG8_WAIT_V(8); PG8_WAIT_L(0); PG8_BAR; PG8_MMA(1, 0, At, B0); PG8_MMA(1, 1, At, B1); PG8_BAR; PG8_SCHED;
            PG8_LDB(B0, 1, 0); PG8_LDB(B1, 1, 1); PG8_SCHED; PG8_LDA(At, 1, 0); PG8_STAGE(PG8_SA(0, 1), a2 + hstepA, voffA);
            PG8_WAIT_V(8); PG8_WAIT_L(0); PG8_BAR; PG8_MMA(0, 0, At, B0); PG8_MMA(0, 1, At, B1); PG8_BAR; PG8_SCHED;
            PG8_LDA(At, 1, 1); PG8_STAGE(PG8_SB(1, 0), b3, voffB); PG8_STAGE(PG8_SB(1, 1), b3 + hstepB, voffB); PG8_STAGE(PG8_SA(1, 0), a3, voffA);
            PG8_WAIT_V(8); PG8_WAIT_L(0); PG8_BAR; PG8_MMA(1, 0, At, B0); PG8_MMA(1, 1, At, B1); PG8_BAR; PG8_SCHED;
            } else {
            PG8_LDB(B0, 0, 0); PG8_SCHED; PG8_LDA(At, 0, 0); PG8_STAGE(PG8_SA(1, 1), a1 + hstepA, voffA);
            PG8_WAIT_L(8); PG8_BAR; PG8_WAIT_L(0); PG8_MMA(0, 0, At, B0); PG8_BAR; PG8_SCHED;
            PG8_LDB(B1, 0, 1); PG8_STAGE(PG8_SB(0, 0), b2, voffB);
            PG8_BAR; PG8_WAIT_L(0); PG8_MMA(0, 1, At, B1); PG8_BAR;
            PG8_LDA(At, 0, 1); PG8_STAGE(PG8_SA(0, 0), a2, voffA);
            PG8_BAR; PG8_WAIT_L(0); PG8_MMA(1, 0, At, B0); PG8_BAR; PG8_SCHED;
            PG8_STAGE(PG8_SB(0, 1), b2 + hstepB, voffB);
            PG8_WAIT_V(6); PG8_BAR; PG8_MMA(1, 1, At, B1); PG8_BAR;
            PG8_LDB(B0, 1, 0); PG8_SCHED; PG8_LDA(At, 1, 0); PG8_STAGE(PG8_SA(0, 1), a2 + hstepA, voffA);
            PG8_WAIT_L(8); PG8_BAR; PG8_WAIT_L(0); PG8_MMA(0, 0, At, B0); PG8_BAR; PG8_SCHED;
            PG8_LDB(B1, 1, 1); PG8_STAGE(PG8_SB(1, 0), b3, voffB);
            PG8_BAR; PG8_WAIT_L(0); PG8_MMA(0, 1, At, B1); PG8_BAR;
            PG8_LDA(At, 1, 1); PG8_STAGE(PG8_SA(1, 0), a3, voffA);
            PG8_BAR; PG8_WAIT_L(0); PG8_MMA(1, 0, At, B0); PG8_BAR; PG8_SCHED;
            PG8_STAGE(PG8_SB(1, 1), b3 + hstepB, voffB);
            PG8_WAIT_V(6); PG8_BAR; PG8_MMA(1, 1, At, B1); PG8_BAR;
            }
        }
        if constexpr (ALIGN_EPI) { if (wr == 0) PG8_BAR; }
        if constexpr (!Epi::AFTER_DRAIN) { E(acc, cur, wr, wc, fr, fq); S.done(cur); }
        if (!has_next) break;
#pragma unroll
        for (int a = 0; a < 2; ++a)
#pragma unroll
            for (int b = 0; b < 2; ++b)
#pragma unroll
                for (int m = 0; m < 4; ++m)
#pragma unroll
                    for (int n = 0; n < 2; ++n) acc[a][b][m][n] = (f32x4){0.f, 0.f, 0.f, 0.f};
        cur = nxt; cA = nA; cB = nB; ++ui;
        if constexpr (ALIGN_EPI) { if (wr == 1) PG8_BAR; }
    }
    PG8_WAIT_V(0);
    if constexpr (!ALIGN_EPI) { if (wr == 0) PG8_BAR; }
    PG8_BAR;
#undef PG8_SA
#undef PG8_SB
#undef PG8_STAGE
#undef PG8_LDA
#undef PG8_LDB
#undef PG8_MMA
#undef PG8_WAIT_V
#undef PG8_WAIT_L
#undef PG8_BAR
#undef PG8_SCHED
}
}


#define XB_TMO      128
#define XB_XCNT(j)  (256  + 64 * (j))
#define XB_XSUB(j)  (1280 + 64 * (j))
#define XB_XGEN(j)  (2304 + 64 * (j))
#define XB_TOP      3328
#define XB_TOPGEN   3392
#define XCD_BAR_WORDS 3456
#define XB_SPIN_CAP (1u << 18)
#define LAS __attribute__((address_space(3)))
DEVI unsigned xb_ld(unsigned* p)              { return __hip_atomic_load(p, __ATOMIC_RELAXED, __HIP_MEMORY_SCOPE_AGENT); }
DEVI unsigned xb_add(unsigned* p, unsigned v) { return __hip_atomic_fetch_add(p, v, __ATOMIC_RELAXED, __HIP_MEMORY_SCOPE_AGENT); }
DEVI unsigned xb_xcc_id() { return (unsigned)__builtin_amdgcn_s_getreg((3 << 11) | 20) & 0xFu; }
#define XB_SPIN(cond, bar) do { unsigned _sp = 0; while (cond) { __builtin_amdgcn_s_sleep(1); \
    if ((++_sp & 255u) == 0u) { if (xb_ld(&(bar)[XB_TMO])) break; if (_sp > XB_SPIN_CAP) { atomicAdd(&(bar)[XB_TMO], 1u); break; } } } } while (0)
struct XcdBarrier { unsigned* bar; unsigned x; volatile LAS unsigned* st; };
DEVI XcdBarrier xcd_barrier_post(unsigned* bar, volatile LAS unsigned* st) {
    XcdBarrier b; b.bar = bar; b.x = xb_xcc_id(); b.st = st;
    if (threadIdx.x == 0) (void)xb_add(&bar[XB_XCNT(b.x)], 1u);
    return b;
}
DEVI void xcd_barrier_complete(unsigned* bar, unsigned x, unsigned& nloc, unsigned& nx) {
    const unsigned G = gridDim.x * gridDim.y * gridDim.z;
    unsigned sum, cnt, mine, sp = 0u;
    for (;;) {
        sum = 0u; cnt = 0u; mine = 0u;
#pragma unroll
        for (unsigned j = 0; j < 16; ++j) { const unsigned c = xb_ld(&bar[XB_XCNT(j)]); sum += c; cnt += (c > 0u) ? 1u : 0u; mine = (j == x) ? c : mine; }
        if (sum == G) break;
        __builtin_amdgcn_s_sleep(1);
        if ((++sp & 255u) == 0u) { if (xb_ld(&bar[XB_TMO])) break; if (sp > XB_SPIN_CAP) { atomicAdd(&bar[XB_TMO], 1u); break; } }
    }
    nloc = mine > 0u ? mine : 1u; nx = cnt > 0u ? cnt : 1u;
}
DEVI void xcd_barrier(const XcdBarrier& b) {
    asm volatile("s_waitcnt vmcnt(0)" ::: "memory");
    __syncthreads();
    if (threadIdx.x == 0) {
        unsigned* bar = b.bar;
        __builtin_amdgcn_s_waitcnt(0);
        unsigned nloc = b.st[0], nx = b.st[1];
        if (nloc == 0u) { xcd_barrier_complete(bar, b.x, nloc, nx); b.st[0] = nloc; b.st[1] = nx; }
        const unsigned old = xb_add(&bar[XB_XSUB(b.x)], 1u);
        const unsigned gen = old / nloc;
        if (old + 1u == (gen + 1u) * nloc) {
            __builtin_amdgcn_fence(__ATOMIC_RELEASE, "agent");
            asm volatile("s_waitcnt vmcnt(0)" ::: "memory");
            const unsigned og = xb_add(&bar[XB_TOP], 1u);
            const unsigned tg = og / nx;
            if (og + 1u == (tg + 1u) * nx) xb_add(&bar[XB_TOPGEN], 1u);
            else XB_SPIN(xb_ld(&bar[XB_TOPGEN]) == tg, bar);
            __builtin_amdgcn_fence(__ATOMIC_ACQUIRE, "agent");
            xb_add(&bar[XB_XGEN(b.x)], 1u);
            asm volatile("s_waitcnt vmcnt(0)" ::: "memory");
        } else {
            XB_SPIN(xb_ld(&bar[XB_XGEN(b.x)]) == gen, bar);
            __builtin_amdgcn_fence(__ATOMIC_ACQUIRE, "agent");
            asm volatile("s_waitcnt vmcnt(0)" ::: "memory");
        }
    }
    __syncthreads();
}

enum { MZ = 0, MVT, MQ, MK, MGATE, MY, MRES, MFFN, MPG, MPLE };
struct EpiGen {
    static constexpr bool PERM = false, AFTER_DRAIN = false;
    int mode, i0;
    const float* f0; const float* f1; const float* f2;
    bf16_t* b0; const bf16_t* b1;
    float* o0; float* o1; float* o2;
    DEVI void operator()(const f32x4 (&acc)[2][2][4][2], const pg8::Unit& u, int wr, int wc, int fr, int fq) const {
        const int rowb = u.pm * 256 + wr * 64 + fr, colb = u.pn * 256 + wc * 32 + 4 * fq;
        float rsv[2][4];
        if (mode == MZ || mode == MQ || mode == MK || mode == MGATE || mode == MPG || mode == MFFN) {
            const float dv = (mode == MQ) ? (1.f / 384.f) : (mode == MK) ? (1.f / 256.f) : (1.f / 1024.f); const float mult = (mode == MQ) ? QSCALE_MLA : 1.f;
            float raw[2][4];
#pragma unroll
            for (int ai = 0; ai < 2; ++ai)
#pragma unroll
                for (int m = 0; m < 4; ++m) raw[ai][m] = f0[rowb + ai * 128 + m * 16];
#pragma unroll
            for (int ai = 0; ai < 2; ++ai)
#pragma unroll
                for (int m = 0; m < 4; ++m) rsv[ai][m] = rsqrtf(raw[ai][m] * dv + EPS) * mult;
        }
        if (mode == MZ) {
            const int colp = u.pn * 256 + wc * 32 + 8 * fq;
            const int c0 = (u.pn == 4 || u.pn == 5) ? 1 : (u.pn == 6 ? 2 : 0);
            const int c1 = (u.pn == 4) ? 1 : (u.pn == 5 ? 2 : 0);
            const bool fl = (u.pn == 6 && wc == 1 && fq == 0);
            f32x4 bf0 = {0.f, 0.f, 0.f, 0.f}, bf1 = {0.f, 0.f, 0.f, 0.f}; if (fl) { bf0 = *(const f32x4*)(f1); bf1 = *(const f32x4*)(f1 + 4); }
#pragma unroll
            for (int ai = 0; ai < 2; ++ai)
#pragma unroll
                for (int m = 0; m < 4; ++m) {
                    const int row = rowb + ai * 128 + m * 16; const float rs = rsv[ai][m]; float sq[2] = {0.f, 0.f};
#pragma unroll
                    for (int bj = 0; bj < 2; ++bj) {
                        const f32x4 v0 = acc[ai][bj][m][0] * rs, v1 = acc[ai][bj][m][1] * rs;
                        u32x4 w; w.x = cvtpk(v0[0], v0[1]); w.y = cvtpk(v0[2], v0[3]); w.z = cvtpk(v1[0], v1[1]); w.w = cvtpk(v1[2], v1[3]);
                        *(u32x4*)(b0 + (size_t)row * NZ + colp + bj * 128) = w;
                        sq[bj] += ((v0[0] * v0[0] + v0[1] * v0[1]) + (v0[2] * v0[2] + v0[3] * v0[3])) + ((v1[0] * v1[0] + v1[1] * v1[1]) + (v1[2] * v1[2] + v1[3] * v1[3]));
                        if (fl && bj == 1) { f32x4 l0, l1;
                            l0[0] = logsig(v0[0] + bf0[0]); l0[1] = logsig(v0[1] + bf0[1]); l0[2] = logsig(v0[2] + bf0[2]); l0[3] = logsig(v0[3] + bf0[3]);
                            l1[0] = logsig(v1[0] + bf1[0]); l1[1] = logsig(v1[1] + bf1[1]); l1[2] = logsig(v1[2] + bf1[2]); l1[3] = logsig(v1[3] + bf1[3]);
                            *(f32x4*)(o0 + (size_t)row * 8) = l0; *(f32x4*)(o0 + (size_t)row * 8 + 4) = l1; }
                    }
                    if (c0 | c1) {
                        float s0 = sq[0], s1 = sq[1];
                        s0 += __shfl_xor(s0, 16); s0 += __shfl_xor(s0, 32); s1 += __shfl_xor(s1, 16); s1 += __shfl_xor(s1, 32);
                        if (fq == 0) {
                            if (c0 == 1) unsafeAtomicAdd(o1 + row, s0); else if (c0 == 2) unsafeAtomicAdd(o2 + row, s0);
                            if (c1 == 1) unsafeAtomicAdd(o1 + row, s1); else if (c1 == 2) unsafeAtomicAdd(o2 + row, s1);
                        }
                    }
                }
        } else if (mode == MVT) {
            const int colp = u.pn * 256 + wc * 32 + 8 * fq; const float dv = i0 ? (1.f / 256.f) : (1.f / 1024.f);
            f32x4 scv[2][2];
#pragma unroll
            for (int bj = 0; bj < 2; ++bj)
#pragma unroll
                for (int n = 0; n < 2; ++n) scv[bj][n] = *(const f32x4*)(f0 + colp + bj * 128 + 4 * n);
#pragma unroll
            for (int bj = 0; bj < 2; ++bj) {
                f32x4 s0 = scv[bj][0], s1 = scv[bj][1];
#pragma unroll
                for (int e = 0; e < 4; ++e) { s0[e] = rsqrtf(s0[e] * dv + EPS); s1[e] = rsqrtf(s1[e] * dv + EPS); }
                const int col = colp + bj * 128, bb = col >> 13, sx = col & 8191;
#pragma unroll
                for (int ai = 0; ai < 2; ++ai)
#pragma unroll
                    for (int m = 0; m < 4; ++m) {
                        const int row = rowb + ai * 128 + m * 16; const f32x4 v0 = acc[ai][bj][m][0] * s0, v1 = acc[ai][bj][m][1] * s1;
                        u32x4 w; w.x = cvtpk(v0[0], v0[1]); w.y = cvtpk(v0[2], v0[3]); w.z = cvtpk(v1[0], v1[1]); w.w = cvtpk(v1[2], v1[3]);
                        *(u32x4*)(b0 + ((size_t)(bb * 512 + row)) * S_ + sx) = w;
                    }
            }
        } else if (mode == MQ) {
            const bool anyrope = ((u.pn * 8 + wc) % 3 == 2) || ((u.pn * 8 + 4 + wc) % 3 == 2);
#pragma unroll
            for (int ai = 0; ai < 2; ++ai) {
                f32x4 cs[4], sn[4];
#pragma unroll
                for (int m = 0; m < 4; ++m) { const int pos = (rowb + ai * 128 + m * 16) & 8191;
                    if (anyrope) { cs[m] = *(const f32x4*)(f1 + pos * 16 + 4 * fq); sn[m] = *(const f32x4*)(f2 + pos * 16 + 4 * fq); } else { cs[m] = (f32x4){1.f, 1.f, 1.f, 1.f}; sn[m] = (f32x4){0.f, 0.f, 0.f, 0.f}; } }
#pragma unroll
                for (int m = 0; m < 4; ++m) {
                    const int row = rowb + ai * 128 + m * 16; const float rs = rsv[ai][m];
#pragma unroll
                    for (int bj = 0; bj < 2; ++bj) {
                        const int g32 = u.pn * 8 + bj * 4 + wc;
                        f32x4 x1 = acc[ai][bj][m][0] * rs, x2 = acc[ai][bj][m][1] * rs;
                        if (g32 % 3 == 2) { const f32x4 c = cs[m], s_ = sn[m]; const f32x4 y1 = x1 * c - x2 * s_, y2 = x2 * c + x1 * s_; x1 = y1; x2 = y2; }
                        const int col = colb + bj * 128;
                        u32x2 w; w.x = cvtpk(x1[0], x1[1]); w.y = cvtpk(x1[2], x1[3]); *(u32x2*)(b0 + (size_t)row * 768 + col) = w;
                        w.x = cvtpk(x2[0], x2[1]); w.y = cvtpk(x2[2], x2[3]); *(u32x2*)(b0 + (size_t)row * 768 + col + 16) = w;
                    }
                }
                asm volatile("" ::: "memory");
            }
        } else if (mode == MK) {
            const int colp = u.pn * 256 + wc * 32 + 8 * fq;
#pragma unroll
            for (int ai = 0; ai < 2; ++ai)
#pragma unroll
                for (int m = 0; m < 4; ++m) {
                    const int row = rowb + ai * 128 + m * 16; const float rs = rsv[ai][m];
#pragma unroll
                    for (int bj = 0; bj < 2; ++bj) {
                        const int col = colp + bj * 128; const f32x4 v0 = acc[ai][bj][m][0] * rs, v1 = acc[ai][bj][m][1] * rs;
                        u32x4 w; w.x = cvtpk(v0[0], v0[1]); w.y = cvtpk(v0[2], v0[3]); w.z = cvtpk(v1[0], v1[1]); w.w = cvtpk(v1[2], v1[3]);
                        *(u32x4*)(b0 + (size_t)row * 768 + (col >> 6) * 96 + (col & 63)) = w;
                    }
                }
        } else if (mode == MGATE) {
            const int colp = u.pn * 256 + wc * 32 + 8 * fq;
            f32x4 bvp[2][2];
#pragma unroll
            for (int bj = 0; bj < 2; ++bj)
#pragma unroll
                for (int n = 0; n < 2; ++n) bvp[bj][n] = *(const f32x4*)(f1 + colp + bj * 128 + 4 * n);
#pragma unroll
            for (int ai = 0; ai < 2; ++ai)
#pragma unroll
                for (int m = 0; m < 4; ++m) {
                    const int row = rowb + ai * 128 + m * 16; const float rs = rsv[ai][m];
#pragma unroll
                    for (int bj = 0; bj < 2; ++bj) {
                        const f32x4 v0 = acc[ai][bj][m][0] * rs + bvp[bj][0], v1 = acc[ai][bj][m][1] * rs + bvp[bj][1];
                        u32x4 w; w.x = cvtpk(sigm(v0[0]), sigm(v0[1])); w.y = cvtpk(sigm(v0[2]), sigm(v0[3])); w.z = cvtpk(sigm(v1[0]), sigm(v1[1])); w.w = cvtpk(sigm(v1[2]), sigm(v1[3]));
                        *(u32x4*)(b0 + (size_t)row * 1024 + colp + bj * 128) = w;
                    }
                }
        } else if (mode == MPG) {
            const int colp = u.pn * 256 + wc * 32 + 8 * fq;
#pragma unroll
            for (int ai = 0; ai < 2; ++ai)
#pragma unroll
                for (int m = 0; m < 4; ++m) {
                    const int row = rowb + ai * 128 + m * 16; const float rs = rsv[ai][m];
#pragma unroll
                    for (int bj = 0; bj < 2; ++bj) {
                        const f32x4 v0 = acc[ai][bj][m][0] * rs, v1 = acc[ai][bj][m][1] * rs;
                        u32x4 w; w.x = cvtpk(sigm(v0[0]), sigm(v0[1])); w.y = cvtpk(sigm(v0[2]), sigm(v0[3])); w.z = cvtpk(sigm(v1[0]), sigm(v1[1])); w.w = cvtpk(sigm(v1[2]), sigm(v1[3]));
                        *(u32x4*)(b0 + (size_t)row * 1024 + colp + bj * 128) = w;
                    }
                }
        } else if (mode == MY) {
            const int colp = u.pn * 256 + wc * 32 + 8 * fq;
#pragma unroll
            for (int ai = 0; ai < 2; ++ai) {
                u32x4 gw[4][2], ow[4][2];
#pragma unroll
                for (int m = 0; m < 4; ++m)
#pragma unroll
                    for (int bj = 0; bj < 2; ++bj) {
                        const size_t ix = (size_t)(rowb + ai * 128 + m * 16) * 1024 + colp + bj * 128;
                        gw[m][bj] = *(const u32x4*)(b1 + ix); if (!i0) ow[m][bj] = *(const u32x4*)(b0 + ix); else ow[m][bj] = (u32x4){0u, 0u, 0u, 0u};
                    }
#pragma unroll
                for (int m = 0; m < 4; ++m)
#pragma unroll
                    for (int bj = 0; bj < 2; ++bj) {
                        const size_t ix = (size_t)(rowb + ai * 128 + m * 16) * 1024 + colp + bj * 128;
                        const u32x4 g4 = gw[m][bj], o4 = ow[m][bj]; const f32x4 a0 = acc[ai][bj][m][0], a1 = acc[ai][bj][m][1];
                        u32x4 w;
                        w.x = cvtpk(bflo(g4.x) * a0[0] + bflo(o4.x), bfhi(g4.x) * a0[1] + bfhi(o4.x)); w.y = cvtpk(bflo(g4.y) * a0[2] + bflo(o4.y), bfhi(g4.y) * a0[3] + bfhi(o4.y));
                        w.z = cvtpk(bflo(g4.z) * a1[0] + bflo(o4.z), bfhi(g4.z) * a1[1] + bfhi(o4.z)); w.w = cvtpk(bflo(g4.w) * a1[2] + bflo(o4.w), bfhi(g4.w) * a1[3] + bfhi(o4.w));
                        *(u32x4*)(b0 + ix) = w;
                    }
            }
        } else if (mode == MRES || mode == MPLE) {
            const int colp = u.pn * 256 + wc * 32 + 8 * fq;
#pragma unroll
            for (int ai = 0; ai < 2; ++ai)
#pragma unroll
                for (int mh = 0; mh < 2; ++mh) {
                    f32x4 bs[2][2][2]; u32x4 gw[2][2];
#pragma unroll
                    for (int mm = 0; mm < 2; ++mm)
#pragma unroll
                        for (int bj = 0; bj < 2; ++bj) {
                            const size_t ix = (size_t)(rowb + ai * 128 + (2 * mh + mm) * 16) * 1024 + colp + bj * 128;
                            bs[mm][bj][0] = *(const f32x4*)(f0 + ix); bs[mm][bj][1] = *(const f32x4*)(f0 + ix + 4);
                            if (mode == MPLE) gw[mm][bj] = *(const u32x4*)(b1 + ix); else gw[mm][bj] = (u32x4){0u, 0u, 0u, 0u};
                        }
#pragma unroll
                    for (int mm = 0; mm < 2; ++mm) {
                        const int m = 2 * mh + mm, row = rowb + ai * 128 + m * 16; float sq = 0.f;
#pragma unroll
                        for (int bj = 0; bj < 2; ++bj) {
                            const size_t ix = (size_t)row * 1024 + colp + bj * 128;
                            f32x4 a0 = acc[ai][bj][m][0], a1 = acc[ai][bj][m][1];
                            if (mode == MPLE) { const u32x4 g4 = gw[mm][bj]; a0[0] *= bflo(g4.x); a0[1] *= bfhi(g4.x); a0[2] *= bflo(g4.y); a0[3] *= bfhi(g4.y); a1[0] *= bflo(g4.z); a1[1] *= bfhi(g4.z); a1[2] *= bflo(g4.w); a1[3] *= bfhi(g4.w); }
                            const f32x4 r0 = bs[mm][bj][0] + a0, r1 = bs[mm][bj][1] + a1; *(f32x4*)(o0 + ix) = r0; *(f32x4*)(o0 + ix + 4) = r1;
                            if (b0) { u32x4 w; w.x = cvtpk(r0[0], r0[1]); w.y = cvtpk(r0[2], r0[3]); w.z = cvtpk(r1[0], r1[1]); w.w = cvtpk(r1[2], r1[3]); *(u32x4*)(b0 + ix) = w; }
                            sq += ((r0[0] * r0[0] + r0[1] * r0[1]) + (r0[2] * r0[2] + r0[3] * r0[3])) + ((r1[0] * r1[0] + r1[1] * r1[1]) + (r1[2] * r1[2] + r1[3] * r1[3]));
                        }
                        sq += __shfl_xor(sq, 16); sq += __shfl_xor(sq, 32);
                        if (fq == 0) unsafeAtomicAdd(o1 + row, sq);
                    }
                    asm volatile("" ::: "memory");
                }
        } else if (mode == MFFN) {
            const int colo = u.pn * 128 + wc * 32 + 8 * fq;
#pragma unroll
            for (int ai = 0; ai < 2; ++ai)
#pragma unroll
                for (int m = 0; m < 4; ++m) {
                    const int row = rowb + ai * 128 + m * 16; const float rs = rsv[ai][m];
                    const f32x4 g0 = acc[ai][0][m][0] * rs, g1 = acc[ai][0][m][1] * rs, u0 = acc[ai][1][m][0] * rs, u1 = acc[ai][1][m][1] * rs;
                    u32x4 w; w.x = cvtpk(g0[0] * sigm(g0[0]) * u0[0], g0[1] * sigm(g0[1]) * u0[1]); w.y = cvtpk(g0[2] * sigm(g0[2]) * u0[2], g0[3] * sigm(g0[3]) * u0[3]);
                    w.z = cvtpk(g1[0] * sigm(g1[0]) * u1[0], g1[1] * sigm(g1[1]) * u1[1]); w.w = cvtpk(g1[2] * sigm(g1[2]) * u1[2], g1[3] * sigm(g1[3]) * u1[3]);
                    *(u32x4*)(b0 + (size_t)row * 2816 + colo) = w;
                }
        }
    }
};

constexpr size_t W_IN = 0;
constexpr size_t W_V  = W_IN + 2816ull * 1024;
constexpr size_t W_G  = W_V + 512ull * 1024;
constexpr size_t W_UQ = W_G + 3072ull * 1024;
constexpr size_t W_UK = W_UQ + 768ull * 384;
constexpr size_t W_UV = W_UK + 512ull * 256;
constexpr size_t W_BA = W_UV + 512ull * 256;
constexpr size_t W_BB = W_BA + 1024ull * 512;
constexpr size_t W_BC = W_BB + 1024ull * 512;
constexpr size_t W_O  = W_BC + 1024ull * 512;
constexpr size_t W_GU = W_O + 1024ull * 1024;
constexpr size_t W_DN = W_GU + 5632ull * 1024;
constexpr size_t W_PG = W_DN + 1024ull * 2816;
constexpr size_t W_PL = W_PG + 1024ull * 1024;
constexpr size_t W_LA = W_PL + 1024ull * 256;
constexpr size_t W_LX = W_LA + 512ull * 64;
constexpr size_t W_LAYER = W_LX + 512ull * 64;
constexpr size_t MiB = 1ull << 20;
constexpr size_t WS_W = 0, WS_XB = 76 * MiB, WS_ZB = 140 * MiB, WS_FVT = 316 * MiB, WS_QM = 348 * MiB, WS_KM = 396 * MiB, WS_VTM = 444 * MiB;
constexpr size_t WS_GS = 348 * MiB, WS_MG = 412 * MiB, WS_PB = 484 * MiB;
constexpr size_t WS_SM = 476 * MiB;
constexpr size_t SM_SSQA = WS_SM, SM_SSQQ = SM_SSQA + 131072, SM_SSQKV = SM_SSQQ + 131072, SM_FLOG = SM_SSQKV + 131072, SM_KBIAS = SM_FLOG + MiB,
                 SM_AGGP = SM_KBIAS + MiB, SM_AGGH = SM_AGGP + 524288, SM_TCOS = SM_AGGH + 524288, SM_TSIN = SM_TCOS + 524288, SM_SSQB = SM_TSIN + 524288, SM_SSQC = SM_SSQB + 131072,
                 SM_BAR = SM_SSQC + 131072, WS_END = 500 * MiB;
static_assert(SM_BAR + 16384 <= WS_PB, "small region");
static_assert(2 * W_LAYER * 2 <= 76 * MiB, "weights");
constexpr int LDS_GEMM = pg8::STAGE_BYTES;
constexpr int LDS_BYTES = LDS_GEMM + 16;

struct Params { const float* in[28]; float* out; unsigned char* ws; int ph_lo, ph_hi; };

enum { CM_ID = 0, CM_WIN, CM_KVK, CM_KVV, CM_GU, CM_LRU };
template <int CM> DEVI void prep_w(unsigned char* smem, bf16_t* dst, int N, int K, const float* __restrict__ src, int ld, int coloff, const float* __restrict__ ks, int G) {
    bf16_t* tile = (bf16_t*)smem;
    const int tid = otid(), nl = tid & 63, k8 = tid >> 6, sn = tid >> 3, sk = tid & 7;
    const int ntn = N >> 6, ntiles = ntn * (K >> 6);
    for (int tl = blockIdx.x; tl < ntiles; tl += G) {
        const int n0 = (tl % ntn) << 6, k0 = (tl / ntn) << 6, n = n0 + nl;
        int sc = 0; float ns = 1.f; bool zero = false;
        if (CM == CM_ID) sc = coloff + n;
        else if (CM == CM_WIN) {
            if (n < 1696) sc = n; else if (n < 1704) sc = 3232 + (n - 1696); else if (n < 1792) zero = true;
            else if (n < 2304) { sc = 1696 + (n - 1792); ns = QSCALE_FOX; } else sc = 2208 + (n - 2304);
        } else if (CM == CM_KVK) sc = (n >> 6) * 128 + (n & 63);
        else if (CM == CM_KVV) sc = (n >> 6) * 128 + 64 + (n & 63);
        else if (CM == CM_GU) { const int tq = n >> 8, wq = n & 255; sc = (wq < 128) ? (128 * tq + wq) : (2816 + 128 * tq + (wq - 128)); }
        else sc = (n >> 6) * 4096 + (n & 63);
        float v[8];
#pragma unroll
        for (int i = 0; i < 8; ++i) { const int k = k0 + k8 + 8 * i; v[i] = zero ? 0.f : src[(size_t)k * ld + sc] * (ks ? ks[k] : 1.f) * ns; }
#pragma unroll
        for (int i = 0; i < 8; ++i) tile[nl * 72 + k8 + 8 * i] = f2bf(v[i]);
        __syncthreads();
        *(u32x4*)(dst + (size_t)(n0 + sn) * K + k0 + 8 * sk) = *(const u32x4*)(tile + sn * 72 + 8 * sk);
        __syncthreads();
    }
}

struct PrepDesc { bf16_t* dst; const float* src; const float* ks; int N, K, ld, coloff, cm; };
DEVI void prep_desc(const Params& P, bf16_t* WB, int g, PrepDesc& d, int& tl) {
    const int L = g / 4824, r = g % 4824; bf16_t* W = WB + (size_t)L * W_LAYER;
    const float* w_in = P.in[3] + (size_t)L * 1024 * 6312; const float* gmix = P.in[2] + L * 1024;
    if (r < 704)       { d = PrepDesc{W + W_IN, w_in, gmix, 2816, 1024, 6312, 0, CM_WIN}; tl = r; }
    else if (r < 832)  { d = PrepDesc{W + W_V, w_in, gmix, 512, 1024, 6312, 2720, CM_ID}; tl = r - 704; }
    else if (r < 1600) { d = PrepDesc{W + W_G, w_in, gmix, 3072, 1024, 6312, 3240, CM_ID}; tl = r - 832; }
    else if (r < 1672) { d = PrepDesc{W + W_UQ, P.in[13] + (size_t)L * 384 * 768, P.in[12] + L * 384, 768, 384, 768, 0, CM_ID}; tl = r - 1600; }
    else if (r < 1704) { d = PrepDesc{W + W_UK, P.in[15] + (size_t)L * 256 * 1024, P.in[14] + L * 256, 512, 256, 1024, 0, CM_KVK}; tl = r - 1672; }
    else if (r < 1736) { d = PrepDesc{W + W_UV, P.in[15] + (size_t)L * 256 * 1024, P.in[14] + L * 256, 512, 256, 1024, 0, CM_KVV}; tl = r - 1704; }
    else if (r < 1864) { d = PrepDesc{W + W_BA, P.in[17] + (size_t)L * 512 * 1024, nullptr, 1024, 512, 1024, 0, CM_ID}; tl = r - 1736; }
    else if (r < 1992) { d = PrepDesc{W + W_BB, P.in[18] + (size_t)L * 512 * 1024, nullptr, 1024, 512, 1024, 0, CM_ID}; tl = r - 1864; }
    else if (r < 2120) { d = PrepDesc{W + W_BC, P.in[19] + (size_t)L * 512 * 1024, nullptr, 1024, 512, 1024, 0, CM_ID}; tl = r - 1992; }
    else if (r < 2376) { d = PrepDesc{W + W_O, P.in[20] + (size_t)L * 1024 * 1024, nullptr, 1024, 1024, 1024, 0, CM_ID}; tl = r - 2120; }
    else if (r < 3784) { d = PrepDesc{W + W_GU, P.in[22] + (size_t)L * 1024 * 5632, P.in[21] + L * 1024, 5632, 1024, 5632, 0, CM_GU}; tl = r - 2376; }
    else if (r < 4488) { d = PrepDesc{W + W_DN, P.in[23] + (size_t)L * 2816 * 1024, nullptr, 1024, 2816, 1024, 0, CM_ID}; tl = r - 3784; }
    else if (r < 4744) { d = PrepDesc{W + W_PG, P.in[25] + (size_t)L * 1024 * 1024, P.in[24] + L * 1024, 1024, 1024, 1024, 0, CM_ID}; tl = r - 4488; }
    else if (r < 4808) { d = PrepDesc{W + W_PL, P.in[26] + (size_t)L * 256 * 1024, nullptr, 1024, 256, 1024, 0, CM_ID}; tl = r - 4744; }
    else if (r < 4816) { d = PrepDesc{W + W_LA, P.in[7] + (size_t)L * 32768, nullptr, 512, 64, 64, 0, CM_LRU}; tl = r - 4808; }
    else               { d = PrepDesc{W + W_LX, P.in[9] + (size_t)L * 32768, nullptr, 512, 64, 64, 0, CM_LRU}; tl = r - 4816; }
}
DEVI void prep_tile_load(const PrepDesc& d, int tl, int nl, int k8, float (&v)[8], int& n0, int& k0) {
    const int ntn = d.N >> 6; n0 = (tl % ntn) << 6; k0 = (tl / ntn) << 6; const int n = n0 + nl;
    int sc = 0; float ns = 1.f; bool zero = false;
    if (d.cm == CM_ID) sc = d.coloff + n;
    else if (d.cm == CM_WIN) {
        if (n < 1696) sc = n; else if (n < 1704) sc = 3232 + (n - 1696); else if (n < 1792) zero = true;
        else if (n < 2304) { sc = 1696 + (n - 1792); ns = QSCALE_FOX; } else sc = 2208 + (n - 2304);
    } else if (d.cm == CM_KVK) sc = (n >> 6) * 128 + (n & 63);
    else if (d.cm == CM_KVV) sc = (n >> 6) * 128 + 64 + (n & 63);
    else if (d.cm == CM_GU) { const int tq = n >> 8, wq = n & 255; sc = (wq < 128) ? (128 * tq + wq) : (2816 + 128 * tq + (wq - 128)); }
    else sc = (n >> 6) * 4096 + (n & 63);
#pragma unroll
    for (int i = 0; i < 8; ++i) { const int k = k0 + k8 + 8 * i; v[i] = zero ? 0.f : d.src[(size_t)k * d.ld + sc] * (d.ks ? d.ks[k] : 1.f) * ns; }
}
DEVI void prep_all(unsigned char* smem, const Params& P, bf16_t* WB, int G) {
    bf16_t* tile = (bf16_t*)smem;
    const int tid = otid(), nl = tid & 63, k8 = tid >> 6, sn = tid >> 3, sk = tid & 7;
    constexpr int NTILE = 2 * 4824;
    for (int g = 4 * blockIdx.x; g < NTILE; g += 4 * G) {
        PrepDesc d[4]; int tl[4], n0[4], k0[4]; float v[4][8];
#pragma unroll
        for (int j = 0; j < 4; ++j) { prep_desc(P, WB, g + j, d[j], tl[j]); prep_tile_load(d[j], tl[j], nl, k8, v[j], n0[j], k0[j]); }
#pragma unroll
        for (int j = 0; j < 4; ++j)
#pragma unroll
            for (int i = 0; i < 8; ++i) tile[j * 64 * 72 + nl * 72 + k8 + 8 * i] = f2bf(v[j][i]);
        __syncthreads();
#pragma unroll
        for (int j = 0; j < 4; ++j) *(u32x4*)(d[j].dst + (size_t)(n0[j] + sn) * d[j].K + k0[j] + 8 * sk) = *(const u32x4*)(tile + j * 64 * 72 + sn * 72 + 8 * sk);
        __syncthreads();
    }
}

DEVI void rope_table(float* tcos, float* tsin, int gtid, int gsz) {
    for (int it = gtid; it < 8192 * 16; it += gsz) {
        const int pos = it >> 4, i = it & 15, j = i & 3, k = i >> 2;
        const double bj = (j == 0) ? 1.0 : (j == 1) ? 0.5623413251903491 : (j == 2) ? 0.31622776601683794 : 0.1778279410038923;
        const double pk = (k == 0) ? 1.0 : (k == 1) ? 0.1 : (k == 2) ? 0.01 : 0.001;
        const float inv = (float)(bj * pk);
        const float ang = __fmul_rn((float)pos, inv);
        const double a = (double)ang; const double kk = rint(a * 0.15915494309189535); const double r = a - kk * 6.283185307179586476925;
        const double r2 = r * r; double sn = 0.0, cs = 0.0;
        double ts = 1.0, tc = 1.0;
#pragma unroll 1
        for (int n = 13; n >= 1; --n) { ts = 1.0 - ts * r2 / (double)((2 * n) * (2 * n + 1)); tc = 1.0 - tc * r2 / (double)((2 * n - 1) * (2 * n)); }
        sn = r * ts; cs = tc;
        tcos[it] = (float)cs; tsin[it] = (float)sn;
    }
}

DEVI void rownorm_phase(const float* __restrict__ x, bf16_t* xb, float* rstd, int G) {
    const int tid_ = otid(); const int lane = tid_ & 63, gw = blockIdx.x * 8 + (tid_ >> 6), nw = G * 8;
    for (int row = gw; row < T_; row += nw) {
        const f32x4* xr = (const f32x4*)(x + (size_t)row * 1024); f32x4 v[4]; float ss = 0.f;
#pragma unroll
        for (int i = 0; i < 4; ++i) { v[i] = xr[lane + 64 * i]; ss += (v[i][0] * v[i][0] + v[i][1] * v[i][1]) + (v[i][2] * v[i][2] + v[i][3] * v[i][3]); }
#pragma unroll
        for (int o = 32; o; o >>= 1) ss += __shfl_xor(ss, o);
        if (lane == 0) rstd[row] = ss;
#pragma unroll
        for (int i = 0; i < 4; ++i) { u32x2 w; w.x = cvtpk(v[i][0], v[i][1]); w.y = cvtpk(v[i][2], v[i][3]); *(u32x2*)(xb + (size_t)row * 1024 + (lane + 64 * i) * 4) = w; }
    }
}
DEVI void finalnorm_phase(float* x, const float* __restrict__ g, const float* __restrict__ ssq, int G) {
    const int tid_ = otid(); const int lane = tid_ & 63, gw = blockIdx.x * 8 + (tid_ >> 6), nw = G * 8;
    for (int row = gw; row < T_; row += nw) {
        f32x4* xr = (f32x4*)(x + (size_t)row * 1024); const float rs = rsqrtf(ssq[row] * (1.f / 1024.f) + EPS);
#pragma unroll
        for (int i = 0; i < 4; ++i) { const f32x4 gv = ((const f32x4*)g)[lane + 64 * i]; xr[lane + 64 * i] = xr[lane + 64 * i] * rs * gv; }
    }
}

DEVI void krope_fill(const bf16_t* __restrict__ zb, bf16_t* km, const float* __restrict__ tcos, const float* __restrict__ tsin, int gtid, int gsz) {
    for (int it = gtid; it < T_ * 8; it += gsz) {
        const int t = it >> 3, h = it & 7, pos = t & 8191;
        const u32x4* src = (const u32x4*)(zb + (size_t)t * NZ + 1664); u32x4 q[4];
#pragma unroll
        for (int i = 0; i < 4; ++i) q[i] = src[i];
        float x[32];
#pragma unroll
        for (int i = 0; i < 4; ++i) { x[8 * i] = bflo(q[i].x); x[8 * i + 1] = bfhi(q[i].x); x[8 * i + 2] = bflo(q[i].y); x[8 * i + 3] = bfhi(q[i].y); x[8 * i + 4] = bflo(q[i].z); x[8 * i + 5] = bfhi(q[i].z); x[8 * i + 6] = bflo(q[i].w); x[8 * i + 7] = bfhi(q[i].w); }
        float y[32];
#pragma unroll
        for (int i4 = 0; i4 < 4; ++i4) {
            const f32x4 c = *(const f32x4*)(tcos + pos * 16 + 4 * i4), s = *(const f32x4*)(tsin + pos * 16 + 4 * i4);
#pragma unroll
            for (int e = 0; e < 4; ++e) { const int i = 4 * i4 + e; y[i] = x[i] * c[e] - x[16 + i] * s[e]; y[16 + i] = x[16 + i] * c[e] + x[i] * s[e]; }
        }
        u32x4* dst = (u32x4*)(km + (size_t)t * 768 + h * 96 + 64);
#pragma unroll
        for (int i = 0; i < 4; ++i) { u32x4 w; w.x = cvtpk(y[8 * i], y[8 * i + 1]); w.y = cvtpk(y[8 * i + 2], y[8 * i + 3]); w.z = cvtpk(y[8 * i + 4], y[8 * i + 5]); w.w = cvtpk(y[8 * i + 6], y[8 * i + 7]); dst[i] = w; }
    }
}
DEVI void fox_cumsum(unsigned char* smem, const float* __restrict__ flog, float* kbias, int G) {
    const int tid_ = otid(); const int lane = tid_ & 63, w = tid_ >> 6;
    double* tot = (double*)smem;
    for (int u = blockIdx.x; u < 32; u += G) {
        const int b = u >> 3, h = u & 7; const int s0 = 1024 * w + 16 * lane;
        const float* fp = flog + ((size_t)b * S_ + s0) * 8 + h;
        float v[16];
#pragma unroll
        for (int i = 0; i < 16; ++i) v[i] = fp[i * 8];
        double c[16]; double run = 0.0;
#pragma unroll
        for (int i = 0; i < 16; ++i) { run += (double)v[i]; c[i] = run; }
        double incl = run;
#pragma unroll
        for (int o = 1; o < 64; o <<= 1) { const double t = __shfl_up(incl, o); if (lane >= o) incl += t; }
        if (lane == 63) tot[w] = incl;
        __syncthreads();
        double base = incl - run;
        for (int k = 0; k < w; ++k) base += tot[k];
        f32x4* kp = (f32x4*)(kbias + ((size_t)(b * 8 + h)) * S_ + s0);
#pragma unroll
        for (int i = 0; i < 4; ++i) { f32x4 o; o[0] = (float)(-(base + c[4 * i]) * 1.4426950408889634); o[1] = (float)(-(base + c[4 * i + 1]) * 1.4426950408889634);
            o[2] = (float)(-(base + c[4 * i + 2]) * 1.4426950408889634); o[3] = (float)(-(base + c[4 * i + 3]) * 1.4426950408889634); kp[i] = o; }
        __syncthreads();
    }
}

DEVI f32x16 mfma32(bf16x8 a, bf16x8 b, f32x16 c) { return __builtin_amdgcn_mfma_f32_32x32x16_bf16(a, b, c, 0, 0, 0); }
DEVI float gelu_tanh(float x) { const float y = 0.7978845608028654f * (x + 0.044715f * x * x * x); const float t = 1.f - 2.f * __builtin_amdgcn_rcpf(1.f + __builtin_amdgcn_exp2f(2.8853900817779268f * y)); return 0.5f * x * (1.f + t); }

template <bool PASS2>
DEVI void lru_unit(unsigned char* smem, bf16_t* zb, const bf16_t* __restrict__ waT, const bf16_t* __restrict__ wxT, const float* __restrict__ conv_w, const float* __restrict__ conv_b,
                   const float* __restrict__ ba, const float* __restrict__ bx, const float* __restrict__ lam, float* aggP, float* aggH, int b, int ch) {
    const int tid = otid(), lane = tid & 63, r32 = lane & 31, hi = lane >> 5, hh = tid >> 6;
    bf16_t* xa = (bf16_t*)(smem + hh * 12800);
    float* xcs = (float*)(smem + hh * 12800 + 4608);
    const unsigned cL = 64 * hh + lane;
    const float cw0 = conv_w[cL], cw1 = conv_w[512 + cL], cw2 = conv_w[1024 + cL], cw3 = conv_w[1536 + cL], cb = conv_b[cL];
    const unsigned cC = 64 * hh + r32;
    const float bav0 = ba[cC], bav1 = ba[cC + 32], bxv0 = bx[cC], bxv1 = bx[cC + 32];
    const float sp80 = 8.f * log1pf(expf(-lam[cC])), sp81 = 8.f * log1pf(expf(-lam[cC + 32]));
    const unsigned tb = (unsigned)b * S_ + (unsigned)ch * 128;
    float um3 = 0.f, um2 = 0.f, um1 = 0.f;
    if (ch > 0) { um3 = bf2f(zb[(tb - 3) * NZ + cL]); um2 = bf2f(zb[(tb - 2) * NZ + cL]); um1 = bf2f(zb[(tb - 1) * NZ + cL]); }
    float hc0 = 0.f, hc1 = 0.f, Pt0 = 1.f, Pt1 = 1.f;
    if (PASS2) {
        const unsigned ab = (unsigned)b * 64 * 512 + cC;
#pragma unroll 8
        for (int k = 0; k < ch; ++k) { hc0 = aggP[ab + k * 512] * hc0 + aggH[ab + k * 512]; hc1 = aggP[ab + k * 512 + 32] * hc1 + aggH[ab + k * 512 + 32]; }
    }
#pragma nounroll
    for (int sb = 0; sb < 4; ++sb) {
        const unsigned t0 = tb + 32 * sb;
#pragma unroll
        for (int i0 = 0; i0 < 32; i0 += 16) {
            float uu[16];
#pragma unroll
            for (int i = 0; i < 16; ++i) uu[i] = bf2f(zb[(t0 + i0 + i) * NZ + cL]);
#pragma unroll
            for (int i = 0; i < 16; ++i) {
                const float xc = cb + cw0 * um3 + cw1 * um2 + cw2 * um1 + cw3 * uu[i]; um3 = um2; um2 = um1; um1 = uu[i];
                xcs[(i0 + i) * 64 + lane] = xc; xa[(i0 + i) * 72 + lane] = f2bf(xc);
            }
        }
        bf16x8 af[4];
#pragma unroll
        for (int s = 0; s < 4; ++s) af[s] = *(const bf16x8*)(xa + r32 * 72 + 16 * s + 8 * hi);
#pragma nounroll
        for (int jh = 0; jh < 2; ++jh) {
            const float bavj = jh ? bav1 : bav0, bxvj = jh ? bxv1 : bxv0, sp8j = jh ? sp81 : sp80;
            f32x16 ca = {}, cx = {};
            { const unsigned wo = (cC + 32 * jh) * 64 + 8 * hi;
#pragma unroll
              for (int s = 0; s < 4; ++s) { const bf16x8 wa_ = *(const bf16x8*)(waT + wo + 16 * s), wx_ = *(const bf16x8*)(wxT + wo + 16 * s); ca = mfma32(af[s], wa_, ca); cx = mfma32(af[s], wx_, cx); } }
            float av[16], bv[16];
            const float* xcp = xcs + 4 * hi * 64 + r32 + 32 * jh;
#pragma unroll
            for (int r = 0; r < 16; ++r) {
                const float xc = xcp[((r & 3) + 8 * (r >> 2)) * 64];
                const float rg = sigm(ca[r] + bavj), ig = sigm(cx[r] + bxvj); const float la = -sp8j * rg;
                av[r] = __expf(la); bv[r] = __builtin_amdgcn_sqrtf(fmaxf(1.f - av[r] * av[r], 0.f)) * ig * xc;
            }
            float A[4], B[4], pA[4], pB[4], hs[4];
#pragma unroll
            for (int g = 0; g < 4; ++g) { float a_ = 1.f, b_ = 0.f;
#pragma unroll
                for (int e = 0; e < 4; ++e) { b_ = av[4 * g + e] * b_ + bv[4 * g + e]; a_ *= av[4 * g + e]; }
                A[g] = a_; B[g] = b_; }
#pragma unroll
            for (int g = 0; g < 4; ++g) { pA[g] = __shfl_xor(A[g], 32); pB[g] = __shfl_xor(B[g], 32); }
            float hcur = jh ? hc1 : hc0;
#pragma unroll
            for (int g = 0; g < 4; ++g) {
                if (hi == 0) { hs[g] = hcur; hcur = A[g] * hcur + B[g]; hcur = pA[g] * hcur + pB[g]; }
                else { hcur = pA[g] * hcur + pB[g]; hs[g] = hcur; hcur = A[g] * hcur + B[g]; }
            }
            if (jh) hc1 = hcur; else hc0 = hcur;
            if (!PASS2) {
                float pp = 1.f;
#pragma unroll
                for (int g = 0; g < 4; ++g) pp *= A[g] * pA[g];
                if (jh) Pt1 *= pp; else Pt0 *= pp;
            } else {
                const unsigned ob = (t0 + 4 * hi) * NZ + 512 + cC + 32 * jh;
#pragma unroll
                for (int g = 0; g < 4; ++g) { float hv = hs[g];
#pragma unroll
                    for (int e = 0; e < 4; ++e) { const int r = 4 * g + e; hv = av[r] * hv + bv[r];
                        const unsigned ix = ob + (unsigned)((8 * g + e) * NZ);
                        const float ug = bf2f(zb[ix]); zb[ix] = f2bf(hv * gelu_tanh(ug)); } }
            }
        }
    }
    if (!PASS2 && hi == 0) {
        const unsigned ix = ((unsigned)b * 64 + ch) * 512 + cC;
        aggP[ix] = Pt0; aggH[ix] = hc0; aggP[ix + 32] = Pt1; aggH[ix + 32] = hc1;
    }
}

template <int DK, bool FOX, int VAR = 0>
DEVI void attn_unit(unsigned char* smem, const bf16_t* Q, int ldq, const bf16_t* __restrict__ Kg, int ldk, const bf16_t* __restrict__ Vt, const float* __restrict__ kbias,
                    bf16_t* O, int ldo, int ocol0, int b, int h, int qb) {
    constexpr int KP = DK + 8, NS = DK / 16, KPR = DK / 8;
    bf16_t* Ks = (bf16_t*)smem;
    bf16_t* Vs = Ks + 2 * 64 * KP;
    float* kbs = (float*)(Vs + 3 * 64 * 72);
    const int tid = otid(), lane = tid & 63, r32 = lane & 31, hi = lane >> 5, w = tid >> 6;
    const size_t rowbase = (size_t)b * S_;
    const int q0 = qb * 256, NT = 4 * qb + 4, tmaxw = 4 * qb + (w >> 1);
    bf16x8 qr[NS];
    { const bf16_t* qp = Q + (rowbase + q0 + 32 * w + r32) * ldq + h * DK + 8 * hi;
#pragma unroll
      for (int s = 0; s < NS; ++s) qr[s] = *(const bf16x8*)(qp + 16 * s); }
    const int kr0 = tid / KPR, kc0 = tid % KPR;
    constexpr bool has1 = (DK == 96);
    const int kr1 = ((tid & 255) + 512) / KPR, kc1 = ((tid & 255) + 512) % KPR;
    const bf16_t* kg0 = Kg + (rowbase + kr0) * ldk + h * DK + 8 * kc0;
    const bf16_t* kg1 = Kg + (rowbase + kr1) * ldk + h * DK + 8 * kc1;
    const int vd = tid >> 3, vc = tid & 7;
    const bf16_t* vg = Vt + ((size_t)(b * 512 + h * 64 + vd)) * S_ + 8 * vc;
    const float* kbg = FOX ? (kbias + ((size_t)(b * 8 + h)) * S_ + lane) : nullptr;
    u32x4 rk0A = {}, rk1A = {}, rvA = {}, rk0B = {}, rk1B = {}, rvB = {}; float rkbA = 0.f, rkbB = 0.f;
#define ATT_LOAD(S_, t) do { rk0##S_ = *(const u32x4*)(kg0 + (size_t)(t) * 64 * ldk); if (has1) rk1##S_ = *(const u32x4*)(kg1 + (size_t)(t) * 64 * ldk); rv##S_ = *(const u32x4*)(vg + (t) * 64); \
        if (FOX) rkb##S_ = kbg[(t) * 64]; } while (0)
#define ATT_STORE(S_, kb_, vb_) do { *(u32x4*)(Ks + (kb_) * 64 * KP + kr0 * KP + 8 * kc0) = rk0##S_; if (has1) *(u32x4*)(Ks + (kb_) * 64 * KP + kr1 * KP + 8 * kc1) = rk1##S_; \
        *(u32x4*)(Vs + (vb_) * 64 * 72 + vd * 72 + 8 * vc) = rv##S_; if (FOX) kbs[(w * 3 + (vb_)) * 64 + lane] = rkb##S_; } while (0)
    ATT_LOAD(A, 0); ATT_STORE(A, 0, 0); ATT_LOAD(B, 1); __syncthreads();
    float m_run = -1e30f, l_run = 0.f; f32x16 o0 = {}, o1 = {}, p0 = {}, p1 = {};
    const int pr = (r32 & 19) | ((r32 & 4) << 1) | ((r32 & 8) >> 1);
    const int qloc = ((w & 1) << 5) + r32;
    const bool grpB = (w >= 4);
#define ATT_QK(kb_) do { const bf16_t* ks = Ks + (kb_) * 64 * KP + pr * KP + 8 * hi; p0 = f32x16{}; p1 = f32x16{}; \
        bf16x8 kf[2 * NS]; \
        _Pragma("unroll") for (int s = 0; s < NS; ++s) { kf[2 * s] = *(const bf16x8*)(ks + 16 * s); kf[2 * s + 1] = *(const bf16x8*)(ks + 32 * KP + 16 * s); } \
        __builtin_amdgcn_sched_barrier(0); \
        _Pragma("unroll") for (int s = 0; s < NS; ++s) { if (VAR == 2) { p0[s] += __builtin_bit_cast(f32x4, kf[2 * s])[0]; p1[s] += __builtin_bit_cast(f32x4, kf[2 * s + 1])[1]; } else { p0 = mfma32(kf[2 * s], qr[s], p0); p1 = mfma32(kf[2 * s + 1], qr[s], p1); } } } while (0)
#define ATT_SMPV(tt, vb_) do { \
        bf16x8 vf[8]; \
        { const bf16_t* vs = Vs + (vb_) * 64 * 72 + r32 * 72 + 8 * hi; \
          _Pragma("unroll") for (int blk = 0; blk < 4; ++blk) { vf[2 * blk] = *(const bf16x8*)(vs + 16 * blk); vf[2 * blk + 1] = *(const bf16x8*)(vs + 32 * 72 + 16 * blk); } } \
        if (FOX) { const float* kb = kbs + (w * 3 + (vb_)) * 64 + 8 * hi; \
            _Pragma("unroll") for (int g8 = 0; g8 < 2; ++g8) { \
                const f32x4 a0 = *(const f32x4*)(kb + 16 * g8), a1 = *(const f32x4*)(kb + 16 * g8 + 4), c0 = *(const f32x4*)(kb + 32 + 16 * g8), c1 = *(const f32x4*)(kb + 32 + 16 * g8 + 4); \
                _Pragma("unroll") for (int e = 0; e < 4; ++e) { p0[8 * g8 + e] += a0[e]; p0[8 * g8 + 4 + e] += a1[e]; p1[8 * g8 + e] += c0[e]; p1[8 * g8 + 4 + e] += c1[e]; } } \
            if ((tt) == tmaxw) { _Pragma("unroll") for (int r = 0; r < 16; ++r) { const int kv = (r & 7) + 8 * hi + 16 * (r >> 3); if (kv > qloc) p0[r] = -INFINITY; if (kv + 32 > qloc) p1[r] = -INFINITY; } } } \
        if (VAR != 1) { float mx = fmaxf(p0[0], p1[0]); \
        _Pragma("unroll") for (int r = 1; r < 16; ++r) mx = fmaxf(mx, fmaxf(p0[r], p1[r])); \
        mx = fmaxf(mx, __shfl_xor(mx, 32)); \
        const float mnew = fmaxf(m_run, mx); const float alpha = __builtin_amdgcn_exp2f(m_run - mnew); m_run = mnew; \
        float rs = 0.f; \
        _Pragma("unroll") for (int r = 0; r < 16; ++r) { p0[r] = __builtin_amdgcn_exp2f(p0[r] - mnew); p1[r] = __builtin_amdgcn_exp2f(p1[r] - mnew); rs += p0[r] + p1[r]; } \
        l_run = l_run * alpha + rs; \
        o0 = o0 * alpha; o1 = o1 * alpha; } \
        bf16x8 pf[4]; \
        _Pragma("unroll") for (int blk = 0; blk < 4; ++blk) { u32x4 pw; const int r0 = 8 * (blk & 1); \
            if (blk < 2) { pw.x = cvtpk(p0[r0], p0[r0 + 1]); pw.y = cvtpk(p0[r0 + 2], p0[r0 + 3]); pw.z = cvtpk(p0[r0 + 4], p0[r0 + 5]); pw.w = cvtpk(p0[r0 + 6], p0[r0 + 7]); } \
            else { pw.x = cvtpk(p1[r0], p1[r0 + 1]); pw.y = cvtpk(p1[r0 + 2], p1[r0 + 3]); pw.z = cvtpk(p1[r0 + 4], p1[r0 + 5]); pw.w = cvtpk(p1[r0 + 6], p1[r0 + 7]); } \
            pf[blk] = __builtin_bit_cast(bf16x8, pw); } \
        __builtin_amdgcn_sched_barrier(0); \
        _Pragma("unroll") for (int blk = 0; blk < 4; ++blk) { if (VAR == 2) { o0[blk] += __builtin_bit_cast(f32x4, vf[2 * blk])[0] * __builtin_bit_cast(f32x4, pf[blk])[0]; o1[blk] += __builtin_bit_cast(f32x4, vf[2 * blk + 1])[1]; } else { o0 = mfma32(vf[2 * blk], pf[blk], o0); o1 = mfma32(vf[2 * blk + 1], pf[blk], o1); } } } while (0)
    int vcur = 0, vprev = 2, vnext = 1;
#define ATT_ITER(t, SL_, SS_) do { \
        { const int tl_ = (VAR == 3) ? 0 : (((t) + 2 < NT) ? (t) + 2 : NT - 1); ATT_LOAD(SL_, tl_); } \
        if (!grpB) { if ((t) < NT && (t) <= tmaxw) { ATT_QK((t) & 1); ATT_SMPV((t), vcur); } } \
        else { if ((t) >= 1 && (t) - 1 <= tmaxw) { ATT_SMPV((t) - 1, vprev); } if ((t) < NT && (t) <= tmaxw) { ATT_QK((t) & 1); } } \
        ATT_STORE(SS_, ((t) + 1) & 1, vnext); \
        __syncthreads(); \
        vprev = vcur; vcur = vnext; vnext = (vnext == 2) ? 0 : vnext + 1; } while (0)
    for (int t = 0; t <= NT; t += 2) {
        ATT_ITER(t, A, B);
        if (t + 1 <= NT) ATT_ITER(t + 1, B, A);
    }
#undef ATT_ITER
#undef ATT_LOAD
#undef ATT_STORE
#undef ATT_QK
#undef ATT_SMPV
    const float lt = l_run + __shfl_xor(l_run, 32); const float inv = 1.f / lt;
    bf16_t* op = O + (rowbase + q0 + 32 * w + r32) * ldo + ocol0 + h * 64 + 4 * hi;
#pragma unroll
    for (int g = 0; g < 4; ++g) {
        u32x2 w2; w2.x = cvtpk(o0[4 * g] * inv, o0[4 * g + 1] * inv); w2.y = cvtpk(o0[4 * g + 2] * inv, o0[4 * g + 3] * inv); *(u32x2*)(op + 8 * g) = w2;
        w2.x = cvtpk(o1[4 * g] * inv, o1[4 * g + 1] * inv); w2.y = cvtpk(o1[4 * g + 2] * inv, o1[4 * g + 3] * inv); *(u32x2*)(op + 32 + 8 * g) = w2;
    }
}

#define SGB(m_, n_) __builtin_amdgcn_sched_group_barrier((m_), (n_), 0)
DEVI float max3f(float a, float b, float c) { return __builtin_fmaxf(__builtin_fmaxf(a, b), c); }
template <int DK, bool FOX, int VAR = 0>
DEVI void attn_unit2(unsigned char* smem, const bf16_t* Q, int ldq, const bf16_t* __restrict__ Kg, int ldk, const bf16_t* __restrict__ Vt, const float* __restrict__ kbias,
                     bf16_t* O, int ldo, int ocol0, int b, int h, int qb) {
    constexpr int KP = DK + 8, NS = DK / 16, KPR = DK / 8;
    bf16_t* Ks = (bf16_t*)smem;
    bf16_t* Vs = Ks + 2 * 64 * KP;
    float* kbs = (float*)(Vs + 3 * 64 * 72);
    const int tid = otid(), lane = tid & 63, r32 = lane & 31, hi = lane >> 5, w = tid >> 6;
    const size_t rowbase = (size_t)b * S_;
    const int q0 = qb * 256, NT = 4 * qb + 4, tmaxw = 4 * qb + (w >> 1);
    bf16x8 qr[NS];
    { const bf16_t* qp = Q + (rowbase + q0 + 32 * w + r32) * ldq + h * DK + 8 * hi;
#pragma unroll
      for (int s = 0; s < NS; ++s) qr[s] = *(const bf16x8*)(qp + 16 * s); }
    const int kr0 = tid / KPR, kc0 = tid % KPR;
    constexpr bool has1 = (DK == 96);
    const int kr1 = ((tid & 255) + 512) / KPR, kc1 = ((tid & 255) + 512) % KPR;
    const bf16_t* kgb = Kg + rowbase * ldk + h * DK;
    const unsigned ko0 = (unsigned)(kr0 * ldk + 8 * kc0), ko1 = (unsigned)(kr1 * ldk + 8 * kc1), kstep = (unsigned)(64 * ldk);
    const int vd = tid >> 3, vc = tid & 7;
    const bf16_t* vgb = Vt + ((size_t)(b * 512 + h * 64)) * S_;
    const unsigned vo = (unsigned)(vd * S_ + 8 * vc);
    const float* kbgb = FOX ? (kbias + ((size_t)(b * 8 + h)) * S_) : nullptr;
    u32x4 rk0A = {}, rk1A = {}, rvA = {}, rk0B = {}, rk1B = {}, rvB = {}; float rkbA = 0.f, rkbB = 0.f;
#define ATT_LOAD(S_, t) do { rk0##S_ = *(const u32x4*)(kgb + (ko0 + (unsigned)(t) * kstep)); if (has1) rk1##S_ = *(const u32x4*)(kgb + (ko1 + (unsigned)(t) * kstep)); rv##S_ = *(const u32x4*)(vgb + (vo + (unsigned)(t) * 64u)); \
        if (FOX) rkb##S_ = kbgb[(unsigned)(t) * 64u + (unsigned)lane]; } while (0)
#define ATT_STORE(S_, kb_, vb_) do { *(u32x4*)(Ks + (kb_) * 64 * KP + kr0 * KP + 8 * kc0) = rk0##S_; if (has1) *(u32x4*)(Ks + (kb_) * 64 * KP + kr1 * KP + 8 * kc1) = rk1##S_; \
        *(u32x4*)(Vs + (vb_) * 64 * 72 + vd * 72 + 8 * vc) = rv##S_; if (FOX) kbs[(w * 3 + (vb_)) * 64 + lane] = rkb##S_; } while (0)
    const int pr = (r32 & 19) | ((r32 & 4) << 1) | ((r32 & 8) >> 1);
    const int qloc = ((w & 1) << 5) + r32;
    float m_run = 0.f, l_run = 0.f, al = 1.f; bool resc = false;
    f32x16 o0 = {}, o1 = {}, pa0 = {}, pa1 = {}, pb0 = {}, pb1 = {}, negm = {};
#define ATT_QKREL(PN, kbuf_, sl_) do { \
        const bf16_t* ks = Ks + (kbuf_) * 64 * KP + pr * KP + 8 * hi; \
        if (FOX) { const float* kb = kbs + (w * 3 + (sl_)) * 64 + 8 * hi; \
            _Pragma("unroll") for (int g8 = 0; g8 < 2; ++g8) { \
                const f32x4 a0 = *(const f32x4*)(kb + 16 * g8), a1 = *(const f32x4*)(kb + 16 * g8 + 4), c0 = *(const f32x4*)(kb + 32 + 16 * g8), c1 = *(const f32x4*)(kb + 32 + 16 * g8 + 4); \
                _Pragma("unroll") for (int e = 0; e < 4; ++e) { PN##0[8 * g8 + e] = a0[e] - m_run; PN##0[8 * g8 + 4 + e] = a1[e] - m_run; PN##1[8 * g8 + e] = c0[e] - m_run; PN##1[8 * g8 + 4 + e] = c1[e] - m_run; } } } \
        _Pragma("unroll") for (int s = 0; s < NS; ++s) { const bf16x8 k0 = *(const bf16x8*)(ks + 16 * s), k1 = *(const bf16x8*)(ks + 32 * KP + 16 * s); \
            if (!FOX && s == 0) { PN##0 = mfma32(k0, qr[0], negm); PN##1 = mfma32(k1, qr[0], negm); } else { PN##0 = mfma32(k0, qr[s], PN##0); PN##1 = mfma32(k1, qr[s], PN##1); } } } while (0)
#define ATT_MASK(PN) do { _Pragma("unroll") for (int r = 0; r < 16; ++r) { const int kv = (r & 7) + 8 * hi + 16 * (r >> 3); if (kv > qloc) PN##0[r] = -INFINITY; if (kv + 32 > qloc) PN##1[r] = -INFINITY; } } while (0)
#define ATT_ROWMAX(PN, mx_) do { \
        float mxa = max3f(PN##0[0], PN##0[1], PN##1[0]), mxb = max3f(PN##0[2], PN##0[3], PN##1[1]); mxa = max3f(mxa, PN##1[2], PN##1[3]); \
        _Pragma("unroll") for (int r = 4; r < 16; r += 4) { mxa = max3f(mxa, PN##0[r], PN##0[r + 1]); mxb = max3f(mxb, PN##0[r + 2], PN##0[r + 3]); mxa = max3f(mxa, PN##1[r], PN##1[r + 1]); mxb = max3f(mxb, PN##1[r + 2], PN##1[r + 3]); } \
        mx_ = fmaxf(mxa, mxb); \
        { auto rr = __builtin_amdgcn_permlane32_swap(__float_as_uint(mx_), __float_as_uint(mx_), false, false); mx_ = fmaxf(__uint_as_float(rr[0]), __uint_as_float(rr[1])); } } while (0)
#define ATT_MOVEREF(PN, dl_) do { m_run += (dl_); \
        _Pragma("unroll") for (int r = 0; r < 16; ++r) { PN##0[r] -= (dl_); PN##1[r] -= (dl_); } \
        if (!FOX) { _Pragma("unroll") for (int r = 0; r < 16; ++r) negm[r] = -m_run; } \
        al = __builtin_amdgcn_exp2f(-(dl_)); resc = true; } while (0)
    ATT_LOAD(A, 0); ATT_STORE(A, 0, 0); ATT_LOAD(B, 1); __syncthreads();
    ATT_STORE(B, 1, 1);
    { const int t2 = (2 < NT) ? 2 : NT - 1, t3 = (3 < NT) ? 3 : NT - 1; ATT_LOAD(A, t2); ATT_LOAD(B, t3); }
    {
        ATT_QKREL(pa, 0, 0);
        if (FOX && tmaxw == 0) ATT_MASK(pa);
        float mx0; ATT_ROWMAX(pa, mx0);
        ATT_MOVEREF(pa, mx0); resc = false; al = 1.f;
    }
    __syncthreads();
#define ATT_BODY(t, PC, PN, MASK_) do { \
        if (resc) { o0 = o0 * al; o1 = o1 * al; l_run *= al; } \
        const bf16_t* vs = Vs + vcur * 64 * 72 + r32 * 72 + 8 * hi; \
        ATT_QKREL(PN, ((t) + 1) & 1, vnext); \
        float rs = 0.f; \
        _Pragma("unroll") for (int r = 0; r < 16; ++r) { PC##0[r] = __builtin_amdgcn_exp2f(PC##0[r]); PC##1[r] = __builtin_amdgcn_exp2f(PC##1[r]); rs += PC##0[r] + PC##1[r]; } \
        l_run += rs; \
        bf16x8 pf[4]; \
        _Pragma("unroll") for (int blk = 0; blk < 4; ++blk) { u32x4 pw; const int r0 = 8 * (blk & 1); \
            if (blk < 2) { pw.x = cvtpk(PC##0[r0], PC##0[r0 + 1]); pw.y = cvtpk(PC##0[r0 + 2], PC##0[r0 + 3]); pw.z = cvtpk(PC##0[r0 + 4], PC##0[r0 + 5]); pw.w = cvtpk(PC##0[r0 + 6], PC##0[r0 + 7]); } \
            else { pw.x = cvtpk(PC##1[r0], PC##1[r0 + 1]); pw.y = cvtpk(PC##1[r0 + 2], PC##1[r0 + 3]); pw.z = cvtpk(PC##1[r0 + 4], PC##1[r0 + 5]); pw.w = cvtpk(PC##1[r0 + 6], PC##1[r0 + 7]); } \
            pf[blk] = __builtin_bit_cast(bf16x8, pw); } \
        _Pragma("unroll") for (int blk = 0; blk < 4; ++blk) { const bf16x8 v0 = *(const bf16x8*)(vs + 16 * blk), v1 = *(const bf16x8*)(vs + 32 * 72 + 16 * blk); o0 = mfma32(v0, pf[blk], o0); o1 = mfma32(v1, pf[blk], o1); } \
        if (MASK_) ATT_MASK(PN); \
        float mxn; ATT_ROWMAX(PN, mxn); \
          \
        SGB(0x100, FOX ? 10 : 6); if (FOX) SGB(0x002, 32); \
        _Pragma("unroll") for (int i_ = 0; i_ < 2 * NS; ++i_) { SGB(0x008, 1); SGB(0x100, 1); SGB(0x002, (DK == 96) ? 8 : 11); } \
        SGB(0x100, 4); \
        _Pragma("unroll") for (int i_ = 0; i_ < 8; ++i_) { SGB(0x008, 1); SGB(0x100, 1); SGB(0x002, 5); } \
        resc = false; \
        if (__any(mxn > 8.f)) { const float dl = fmaxf(mxn, 0.f); ATT_MOVEREF(PN, dl); } \
    } while (0)
    int vcur = 0, vnext = 1, vnn = 2;
#define ATT_ITER(t, PC, PN, SL_, SS_) do { \
          \
        if (VAR != 5) { ATT_STORE(SS_, (t) & 1, vnn); } \
        { const int tl_ = (VAR == 3) ? 0 : (((t) + 4 < NT) ? (t) + 4 : NT - 1); if (VAR != 5) ATT_LOAD(SS_, tl_); } \
        if ((t) <= tmaxw) { if (FOX && (t) + 1 == tmaxw) ATT_BODY(t, PC, PN, true); else ATT_BODY(t, PC, PN, false); } \
        if (VAR != 5 && VAR != 6) __syncthreads(); \
        { const int v_ = vcur; vcur = vnext; vnext = vnn; vnn = v_; } } while (0)
    for (int t = 0; t < NT; t += 2) {
        ATT_ITER(t, pa, pb, B, A);
        ATT_ITER(t + 1, pb, pa, A, B);
    }
#undef ATT_ITER
#undef ATT_BODY
#undef ATT_QKREL
#undef ATT_MASK
#undef ATT_ROWMAX
#undef ATT_MOVEREF
#undef ATT_LOAD
#undef ATT_STORE
    const float lt = l_run + __shfl_xor(l_run, 32); const float inv = 1.f / lt;
    bf16_t* op = O + (rowbase + q0 + 32 * w + r32) * ldo + ocol0 + h * 64 + 4 * hi;
#pragma unroll
    for (int g = 0; g < 4; ++g) {
        u32x2 w2; w2.x = cvtpk(o0[4 * g] * inv, o0[4 * g + 1] * inv); w2.y = cvtpk(o0[4 * g + 2] * inv, o0[4 * g + 3] * inv); *(u32x2*)(op + 8 * g) = w2;
        w2.x = cvtpk(o1[4 * g] * inv, o1[4 * g + 1] * inv); w2.y = cvtpk(o1[4 * g + 2] * inv, o1[4 * g + 3] * inv); *(u32x2*)(op + 32 + 8 * g) = w2;
    }
}

constexpr int NPHASE = 20;
template <int ph> DEVI void phase_body(const Params& P, unsigned char* lds, const int G, const int vcu, const bool dup = false) {
    const int gsz = G * 512;
    const int tid = otid(), gtid = blockIdx.x * 512 + tid;
    unsigned char* ws = P.ws;
#define PIN(i) (P.in[i])
    bf16_t* const WB = (bf16_t*)(ws + WS_W);
    bf16_t* const XB = (bf16_t*)(ws + WS_XB); bf16_t* const ZB = (bf16_t*)(ws + WS_ZB); bf16_t* const FVT = (bf16_t*)(ws + WS_FVT);
    bf16_t* const QM = (bf16_t*)(ws + WS_QM); bf16_t* const KM = (bf16_t*)(ws + WS_KM); bf16_t* const VTM = (bf16_t*)(ws + WS_VTM);
    bf16_t* const GS = (bf16_t*)(ws + WS_GS); bf16_t* const MG = (bf16_t*)(ws + WS_MG); bf16_t* const PB = (bf16_t*)(ws + WS_PB);
    float* const SSQA = (float*)(ws + SM_SSQA); float* const SSQB = (float*)(ws + SM_SSQB); float* const SSQC = (float*)(ws + SM_SSQC);
    float* const SSQQ = (float*)(ws + SM_SSQQ); float* const SSQKV = (float*)(ws + SM_SSQKV);
    float* const FLOG = (float*)(ws + SM_FLOG); float* const KBIAS = (float*)(ws + SM_KBIAS); float* const AGGP = (float*)(ws + SM_AGGP); float* const AGGH = (float*)(ws + SM_AGGH);
    float* const TCOS = (float*)(ws + SM_TCOS); float* const TSIN = (float*)(ws + SM_TSIN);
    float* const OUT = P.out;
    const float* const XIN = PIN(0);
    if (ph == 0) {
        prep_all(lds, P, WB, G);
        rope_table(TCOS, TSIN, gtid, gsz);
        for (int i = gtid; i < T_; i += gsz) { SSQQ[i] = 0.f; SSQKV[i] = 0.f; }
        rownorm_phase(XIN, XB, SSQA, G);
    } else if (ph == NPHASE - 1) {
        finalnorm_phase(OUT, PIN(27), SSQA, G);
    } else {
        constexpr int L = (ph - 1) / 9, sp = (ph - 1) % 9;
        const bf16_t* W = WB + (size_t)L * W_LAYER;
        constexpr int ng = (sp == 0) ? 2 : (sp == 1) ? 3 : (sp == 3) ? 6 : (sp == 2) ? 0 : 1;
        if (sp == 0) {
            for (int i = gtid; i < T_; i += gsz) { SSQB[i] = 0.f; SSQC[i] = 0.f; }
            const float* pl = PIN(1) + (size_t)L * T_ * 256;
            for (int i = gtid; i < T_ * 256 / 8; i += gsz) {
                const f32x4 a = ((const f32x4*)pl)[2 * i], c = ((const f32x4*)pl)[2 * i + 1];
                u32x4 w4; w4.x = cvtpk(a[0], a[1]); w4.y = cvtpk(a[2], a[3]); w4.z = cvtpk(c[0], c[1]); w4.w = cvtpk(c[2], c[3]); ((u32x4*)PB)[i] = w4;
            }
        } else if (sp == 1) {
            krope_fill(ZB, KM, TCOS, TSIN, gtid, gsz);
            fox_cumsum(lds, FLOG, KBIAS, G);
            for (int u = blockIdx.x; u < 256; u += G) {
#ifndef NO_LRU
                lru_unit<false>(lds, ZB, W + W_LA, W + W_LX, PIN(5) + L * 2048, PIN(6) + L * 512, PIN(8) + L * 512, PIN(10) + L * 512, PIN(11) + L * 512, AGGP, AGGH, u >> 6, u & 63);
#endif
            }
            __syncthreads();
        } else if (sp == 2) {
#ifdef PROBE_ATTN_VAR
            if (L == 0) for (int deal = vcu; deal < 512; deal += G) {
                const int ty = deal >> 8, idx = deal & 255, bh = idx >> 3, s = idx & 7, b = bh >> 3, h = bh & 7;
                for (int i = 0; i < 4; ++i) {
                    const int qb = (i == 0) ? s : (i == 1) ? 15 - s : (i == 2) ? 16 + s : 31 - s;
                    if (ty == 0) attn_unit2<64, true, PROBE_ATTN_VAR>(lds, ZB + 1792, NZ, ZB + 2304, NZ, FVT, KBIAS, (bf16_t*)OUT, 2048, 0, b, h, qb);
                    else attn_unit2<96, false, PROBE_ATTN_VAR>(lds, QM, 768, KM, 768, VTM, nullptr, (bf16_t*)OUT, 2048, 512, b, h, qb);
                }
            }
#endif
            for (int deal = vcu; deal < 512; deal += G) {
                const int ty = deal >> 8, idx = deal & 255, bh = idx >> 3, s = idx & 7, b = bh >> 3, h = bh & 7;
                for (int i = 0; i < 4; ++i) {
                    const int qb = (i == 0) ? s : (i == 1) ? 15 - s : (i == 2) ? 16 + s : 31 - s;
#ifndef NO_ATTN
                    if (ty == 0) attn_unit2<64, true>(lds, ZB + 1792, NZ, ZB + 2304, NZ, FVT, KBIAS, ZB, NZ, 1792, b, h, qb);
                    else attn_unit2<96, false>(lds, QM, 768, KM, 768, VTM, nullptr, ZB, NZ, 1024, b, h, qb);
#endif
                }
            }
            for (int u = blockIdx.x; u < 256; u += G) {
#ifndef NO_LRU
                lru_unit<true>(lds, ZB, W + W_LA, W + W_LX, PIN(5) + L * 2048, PIN(6) + L * 512, PIN(8) + L * 512, PIN(10) + L * 512, PIN(11) + L * 512, AGGP, AGGH, u >> 6, u & 63);
#endif
            }
        } else if (sp == 5) {
            for (int i = gtid; i < T_; i += gsz) { SSQA[i] = 0.f; SSQQ[i] = 0.f; SSQKV[i] = 0.f; }
        }
#pragma nounroll
        for (int gi = 0; gi < ng; ++gi) {
#ifdef PROBE_GI_PARITY
            if (dup && (gi & 1) != PROBE_GI_PARITY) continue;
#endif
            pg8::Gemm g{}; EpiGen E{};
            if (sp == 0) {
                if (gi == 0) { g = pg8::Gemm{XB, W + W_IN, T_, 2816, 1024, 1024, 1024, 1}; E.mode = MZ; E.f0 = SSQA; E.f1 = PIN(16) + L * 8; E.b0 = ZB; E.o0 = FLOG; E.o1 = SSQQ; E.o2 = SSQKV; }
                else { g = pg8::Gemm{W + W_V, XB, 512, T_, 1024, 1024, 1024, 1}; E.mode = MVT; E.i0 = 0; E.f0 = SSQA; E.b0 = FVT; }
            } else if (sp == 1) {
                if (gi == 0) { g = pg8::Gemm{ZB + 1024, W + W_UQ, T_, 768, 384, NZ, 384, 0}; E.mode = MQ; E.f0 = SSQQ; E.f1 = TCOS; E.f2 = TSIN; E.b0 = QM; }
                else if (gi == 1) { g = pg8::Gemm{ZB + 1408, W + W_UK, T_, 512, 256, NZ, 256, 1}; E.mode = MK; E.f0 = SSQKV; E.b0 = KM; }
                else { g = pg8::Gemm{W + W_UV, ZB + 1408, 512, T_, 256, 256, NZ, 1}; E.mode = MVT; E.i0 = 1; E.f0 = SSQKV; E.b0 = VTM; }
            } else if (sp == 3) {
                const int br = gi >> 1;
                if ((gi & 1) == 0) { g = pg8::Gemm{XB, W + W_G + (size_t)br * 1024 * 1024, T_, 1024, 1024, 1024, 1024, 1}; E.mode = MGATE; E.f0 = SSQA; E.f1 = PIN(4) + L * 3072 + br * 1024; E.b0 = GS; }
                else { const bf16_t* A = (br == 0) ? ZB + 512 : (br == 1) ? ZB + 1024 : ZB + 1792; const bf16_t* Bw = W + ((br == 0) ? W_BA : (br == 1) ? W_BB : W_BC);
                       g = pg8::Gemm{A, Bw, T_, 1024, 512, NZ, 512, 1}; E.mode = MY; E.i0 = (br == 0); E.b1 = GS; E.b0 = MG; }
            } else if (sp == 4) { g = pg8::Gemm{MG, W + W_O, T_, 1024, 1024, 1024, 1024, 1}; E.mode = MRES; E.f0 = (L == 0) ? XIN : OUT; E.o0 = OUT; E.b0 = XB; E.o1 = SSQB; }
            else if (sp == 5) { g = pg8::Gemm{XB, W + W_GU, T_, 5632, 1024, 1024, 1024, 1}; E.mode = MFFN; E.f0 = SSQB; E.b0 = ZB; }
            else if (sp == 6) { g = pg8::Gemm{ZB, W + W_DN, T_, 1024, 2816, 2816, 2816, 1}; E.mode = MRES; E.f0 = OUT; E.o0 = OUT; E.b0 = XB; E.o1 = SSQC; }
            else if (sp == 7) { g = pg8::Gemm{XB, W + W_PG, T_, 1024, 1024, 1024, 1024, 1}; E.mode = MPG; E.f0 = SSQC; E.b0 = GS; }
            else { g = pg8::Gemm{PB, W + W_PL, T_, 1024, 256, 256, 256, 1}; E.mode = MPLE; E.b1 = GS; E.f0 = OUT; E.o0 = OUT; E.b0 = (L == 1) ? nullptr : XB; E.o1 = SSQA; }
            pg8::StaticOrder S; S.init(g.M, g.N, G, (int)blockIdx.x);
#ifndef NO_GEMM
            pg8::gemm_phase<EpiGen, pg8::StaticOrder, true, true>((PG8_LAS unsigned char*)lds, g, S, E);
#endif
            __syncthreads();
        }
    }
}
template <int ph> DEVI void run_phases(const Params& P, unsigned char* lds, const int G, const int vcu, const XcdBarrier& bar) {
    if constexpr (ph < NPHASE) {
        if (ph >= P.ph_lo && ph < P.ph_hi) {
            phase_body<ph>(P, lds, G, vcu);
#ifdef PROBE_DUP_PH
            if (ph == PROBE_DUP_PH) { xcd_barrier(bar); phase_body<ph>(P, lds, G, vcu, true); }
#endif
            if (ph + 1 < P.ph_hi) xcd_barrier(bar);
        }
        run_phases<ph + 1>(P, lds, G, vcu, bar);
    }
}
__global__ void __launch_bounds__(512, 2) mk_fwd(Params P) {
    extern __shared__ __attribute__((aligned(16))) unsigned char lds[];
    const int G = gridDim.x;
    const int vcu = (G % 8 == 0) ? ((int)(blockIdx.x % 8) * (G / 8) + (int)(blockIdx.x / 8)) : (int)blockIdx.x;
    volatile LAS unsigned* st = (volatile LAS unsigned*)((LAS unsigned char*)lds + LDS_GEMM);
    if (threadIdx.x < 4) st[threadIdx.x] = 0u;
    __syncthreads();
    XcdBarrier bar; bar.bar = (unsigned*)(P.ws + SM_BAR); bar.x = 0; bar.st = st;
    if (P.ph_hi - P.ph_lo > 1) bar = xcd_barrier_post((unsigned*)(P.ws + SM_BAR), st);
    if (P.ph_lo > P.ph_hi) cg::this_grid().sync();
    run_phases<0>(P, lds, G, vcu, bar);
}

extern "C" void kernel_launch(void* const* d_in, const int* in_sizes, int n_in, void* d_out, int out_size, void* d_ws, size_t ws_size, hipStream_t stream) {
    static int grid = 0;
    if (grid == 0) {
        if (n_in != 28 || ws_size < WS_END) { fprintf(stderr, "kernel_launch: unexpected n_in %d / ws_size %zu (need %zu)\n", n_in, ws_size, (size_t)WS_END); grid = -1; return; }
        int dev = 0, cus = 0, per_cu = 0;
        (void)hipGetDevice(&dev); (void)hipDeviceGetAttribute(&cus, hipDeviceAttributeMultiprocessorCount, dev);
        if (hipFuncSetAttribute((const void*)mk_fwd, hipFuncAttributeMaxDynamicSharedMemorySize, LDS_BYTES) != hipSuccess) { fprintf(stderr, "kernel_launch: hipFuncSetAttribute failed\n"); grid = -1; return; }
        if (hipOccupancyMaxActiveBlocksPerMultiprocessor(&per_cu, (const void*)mk_fwd, 512, LDS_BYTES) != hipSuccess || per_cu < 1) { fprintf(stderr, "kernel_launch: occupancy query says %d\n", per_cu); per_cu = 1; }
        (void)hipGetLastError();
        grid = cus;
        if (grid <= 0) grid = 256;
    }
    if (grid < 0) return;
    (void)hipMemsetAsync((unsigned char*)d_ws + SM_BAR, 0, XCD_BAR_WORDS * 4, stream);
    Params p{};
    for (int i = 0; i < 28; ++i) p.in[i] = (const float*)d_in[i];
    p.out = (float*)d_out; p.ws = (unsigned char*)d_ws;
#if MK_MULTI
    for (int ph = 0; ph < NPHASE; ++ph) { p.ph_lo = ph; p.ph_hi = ph + 1; hipLaunchKernelGGL(mk_fwd, dim3(grid), dim3(512), LDS_BYTES, stream, p); }
#else
    p.ph_lo = 0; p.ph_hi = NPHASE;
    void* args[] = {&p};
    hipError_t e = hipLaunchCooperativeKernel((const void*)mk_fwd, dim3(grid), dim3(512), args, LDS_BYTES, stream);
    if (e != hipSuccess) fprintf(stderr, "kernel_launch: cooperative launch failed: %s (grid %d)\n", hipGetErrorString(e), grid);
#endif
}
```
